# Optimizing an MI355X kernel written in HIP

```python
import math
import jax, jax.numpy as jnp
from jax import lax
import numpy as np

D_MODEL = 1024
BATCH = 4
SEQ = 4096
DEPTH = 4

CHUNK = 64
Q_BLOCK = 128
HEAD_DIM = 64
A_HEADS = 4
B_HEADS = 8
C_HEADS = 8
IDX_HEADS = 4
IDX_DIM = 64
TOPK_MAX = 256
N_BRANCHES = 3
D_FF = 4 * D_MODEL
PLE_DIM = 256
ROPE_THETA = 10000.0
EPS = 1e-6

A_QK = A_HEADS * 2 * HEAD_DIM
A_V = A_HEADS * 2 * HEAD_DIM
A_WIDTH = A_V
B_WIDTH = B_HEADS * HEAD_DIM
C_WIDTH = C_HEADS * HEAD_DIM
IN_SPLITS = (A_QK, A_QK, A_V, B_WIDTH, B_WIDTH, B_WIDTH, C_WIDTH, C_WIDTH, C_WIDTH,
             IDX_HEADS * IDX_DIM, IDX_DIM, IDX_HEADS, N_BRANCHES * D_MODEL)
W_IN_COLS = (2 * A_QK + A_V + 3 * B_WIDTH + 3 * C_WIDTH + IDX_HEADS * IDX_DIM + IDX_DIM
             + IDX_HEADS + N_BRANCHES * D_MODEL)

kernel_name = "hybrid_diff_stickbreak_dsa_block"


def rmsnorm(x, g):
    xf = x.astype(jnp.float32)
    y = xf * lax.rsqrt(jnp.mean(xf * xf, axis=-1, keepdims=True) + EPS)
    return (y * g.astype(jnp.float32)).astype(x.dtype)


def rope_tables(positions, dim):
    inv = ROPE_THETA ** (-jnp.arange(0, dim, 2, dtype=jnp.float32) / dim)
    ang = positions.astype(jnp.float32)[..., None] * inv
    return jnp.cos(ang), jnp.sin(ang)


def apply_rope(x, cos, sin):
    c = cos[:, :, None, :]
    s = sin[:, :, None, :]
    xf = x.astype(jnp.float32)
    x1, x2 = jnp.split(xf, 2, axis=-1)
    return jnp.concatenate([x1 * c - x2 * s, x2 * c + x1 * s], axis=-1).astype(x.dtype)


def sweep_query_blocks(fn, *arrays):
    b, s = arrays[0].shape[:2]
    nb = s // Q_BLOCK
    blocks = tuple(jnp.moveaxis(a.reshape((b, nb, Q_BLOCK) + a.shape[2:]), 1, 0) for a in arrays)
    out = lax.map(lambda args: fn(args[0], *args[1:]), (jnp.arange(nb), *blocks))
    return jnp.moveaxis(out, 0, 1).reshape((b, s) + out.shape[3:])


def block_positions(blk, n_keys):
    q_pos = blk * Q_BLOCK + jnp.arange(Q_BLOCK)
    k_pos = jnp.arange(n_keys)
    chunk_ok = (k_pos[None, :] // CHUNK) <= (q_pos[:, None] // CHUNK)
    return q_pos, k_pos, chunk_ok


def diff_attention(q, k, v, lam, lam_init, subln_g):
    n_keys = k.shape[1]
    scale = HEAD_DIM ** -0.5

    def block(blk, qb):
        _, _, chunk_ok = block_positions(blk, n_keys)
        s = jnp.einsum('bqhcd,bkhcd->bhcqk', qb, k).astype(jnp.float32) * scale
        s = jnp.where(chunk_ok, s, -jnp.inf)
        pr = jax.nn.softmax(s, axis=-1)
        attn = (pr[:, :, 0] - lam * pr[:, :, 1]).astype(v.dtype)
        return jnp.einsum('bhqk,bkhe->bqhe', attn, v)

    o = sweep_query_blocks(block, q)
    return rmsnorm(o, subln_g) * (1.0 - lam_init)


def stick_breaking_attention(q, k, v):
    n_keys = k.shape[1]
    scale = HEAD_DIM ** -0.5

    def block(blk, qb):
        q_pos, k_pos, _ = block_positions(blk, n_keys)
        strict = k_pos[None, :] < q_pos[:, None]
        z = jnp.einsum('bqhd,bkhd->bhqk', qb, k).astype(jnp.float32) * scale
        log_beta = jax.nn.log_sigmoid(z)
        log_one_minus = jnp.where(strict, jax.nn.log_sigmoid(-z), 0.0)
        key_axis = log_one_minus.ndim - 1
        later = lax.cumsum(log_one_minus, axis=key_axis, reverse=True) - log_one_minus
        a = jnp.where(strict, jnp.exp(log_beta + later), 0.0).astype(v.dtype)
        return jnp.einsum('bhqk,bkhd->bqhd', a, v)

    return sweep_query_blocks(block, q)


def dsa_attention(q, k, v, qi, ki, wi):
    n_keys = k.shape[1]
    topk = min(TOPK_MAX, n_keys // 4)
    scale = HEAD_DIM ** -0.5

    def block(blk, qb, qib, wib):
        q_pos, _, chunk_ok = block_positions(blk, n_keys)
        idx_s = jnp.einsum('bqhd,bkd->bqhk', qib, ki).astype(jnp.float32) * (IDX_DIM ** -0.5)
        score = jnp.einsum('bqh,bqhk->bqk', wib.astype(jnp.float32) * (IDX_HEADS ** -0.5),
                           jax.nn.relu(idx_s))
        score = jnp.where(chunk_ok, score, -jnp.inf)
        _, sel = lax.top_k(score, topk)
        ok = (sel // CHUNK) <= (q_pos[None, :, None] // CHUNK)
        kg = jax.vmap(lambda kb, ib: kb[ib])(k, sel)
        vg = jax.vmap(lambda vb, ib: vb[ib])(v, sel)
        s = jnp.einsum('bqhd,bqkhd->bhqk', qb, kg).astype(jnp.float32) * scale
        s = jnp.where(ok[:, None], s, -jnp.inf)
        pr = jax.nn.softmax(s, axis=-1).astype(v.dtype)
        return jnp.einsum('bhqk,bqkhd->bqhd', pr, vg)

    return sweep_query_blocks(block, q, qi, wi)


def setup_inputs(seed: int = 0) -> dict:
    key = jax.random.key(seed)
    ks = iter(jax.random.split(key, 32))

    def dense(shape, fan_in):
        return jax.random.normal(next(ks), shape, jnp.float32) * (fan_in ** -0.5)

    def gain(shape):
        return 1.0 + 0.05 * jax.random.normal(next(ks), shape, jnp.float32)

    x = jax.random.normal(next(ks), (BATCH, SEQ, D_MODEL), jnp.float32)
    p = jax.random.normal(next(ks), (DEPTH, BATCH, SEQ, PLE_DIM), jnp.float32)
    offset = jax.random.randint(next(ks), (BATCH, 1), 0, 16, dtype=jnp.int32) * CHUNK
    positions = (offset + jnp.arange(SEQ, dtype=jnp.int32)[None, :]).astype(jnp.int32)
    return {
        "x": x,
        "p": p,
        "positions": positions,
        "attn_norm": gain((DEPTH, D_MODEL)),
        "w_in": dense((DEPTH, D_MODEL, W_IN_COLS), D_MODEL),
        "a_q_norm": gain((DEPTH, HEAD_DIM)),
        "a_k_norm": gain((DEPTH, HEAD_DIM)),
        "a_lambda": 0.1 * jax.random.normal(next(ks), (DEPTH, 4, HEAD_DIM), jnp.float32),
        "a_subln": gain((DEPTH, 2 * HEAD_DIM)),
        "c_q_norm": gain((DEPTH, HEAD_DIM)),
        "c_k_norm": gain((DEPTH, HEAD_DIM)),
        "idx_k_norm": gain((DEPTH, IDX_DIM)),
        "w_br_a": dense((DEPTH, A_WIDTH, D_MODEL), A_WIDTH),
        "w_br_b": dense((DEPTH, B_WIDTH, D_MODEL), B_WIDTH),
        "w_br_c": dense((DEPTH, C_WIDTH, D_MODEL), C_WIDTH),
        "w_out": dense((DEPTH, D_MODEL, D_MODEL), D_MODEL),
        "mlp_norm": gain((DEPTH, D_MODEL)),
        "w_up": dense((DEPTH, D_MODEL, D_FF), D_MODEL),
        "w_down": dense((DEPTH, D_FF, D_MODEL), D_FF),
        "ple_norm": gain((DEPTH, D_MODEL)),
        "w_ple_gate": dense((DEPTH, D_MODEL, D_MODEL), D_MODEL),
        "w_ple_proj": dense((DEPTH, PLE_DIM, D_MODEL), PLE_DIM),
    }


def reference(x, p, positions, attn_norm, w_in, a_q_norm, a_k_norm, a_lambda, a_subln,
              c_q_norm, c_k_norm, idx_k_norm, w_br_a, w_br_b, w_br_c, w_out,
              mlp_norm, w_up, w_down, ple_norm, w_ple_gate, w_ple_proj):
    b, s = x.shape[:2]
    cos, sin = rope_tables(positions, HEAD_DIM)
    offsets = [int(o) for o in np.cumsum(IN_SPLITS)[:-1]]
    for i in range(DEPTH):
        lam_init = 0.8 - 0.6 * math.exp(-0.3 * i)
        h = rmsnorm(x, attn_norm[i])
        proj = h @ w_in[i]
        (aq, ak, av, bq, bk, bv, cq, ck, cv, iq, ik, iw, gl) = jnp.split(proj, offsets, axis=-1)

        aq = apply_rope(rmsnorm(aq.reshape(b, s, 2 * A_HEADS, HEAD_DIM), a_q_norm[i]), cos, sin)
        ak = apply_rope(rmsnorm(ak.reshape(b, s, 2 * A_HEADS, HEAD_DIM), a_k_norm[i]), cos, sin)
        lp = a_lambda[i].astype(jnp.float32)
        lam = jnp.exp(jnp.sum(lp[0] * lp[1])) - jnp.exp(jnp.sum(lp[2] * lp[3])) + lam_init
        y_a = diff_attention(aq.reshape(b, s, A_HEADS, 2, HEAD_DIM),
                             ak.reshape(b, s, A_HEADS, 2, HEAD_DIM),
                             av.reshape(b, s, A_HEADS, 2 * HEAD_DIM),
                             lam, lam_init, a_subln[i]).reshape(b, s, A_WIDTH)

        y_b = stick_breaking_attention(bq.reshape(b, s, B_HEADS, HEAD_DIM),
                                       bk.reshape(b, s, B_HEADS, HEAD_DIM),
                                       bv.reshape(b, s, B_HEADS, HEAD_DIM)).reshape(b, s, B_WIDTH)

        cq = apply_rope(rmsnorm(cq.reshape(b, s, C_HEADS, HEAD_DIM), c_q_norm[i]), cos, sin)
        ck = apply_rope(rmsnorm(ck.reshape(b, s, C_HEADS, HEAD_DIM), c_k_norm[i]), cos, sin)
        iq = apply_rope(iq.reshape(b, s, IDX_HEADS, IDX_DIM), cos, sin)
        ik = apply_rope(rmsnorm(ik, idx_k_norm[i])[:, :, None, :], cos, sin)[:, :, 0]
        y_c = dsa_attention(cq, ck, cv.reshape(b, s, C_HEADS, HEAD_DIM),
                            iq, ik, iw).reshape(b, s, C_WIDTH)

        gates = jax.nn.sigmoid(gl.reshape(b, s, N_BRANCHES, D_MODEL).astype(jnp.float32)).astype(x.dtype)
        merged = (gates[:, :, 0] * (y_a @ w_br_a[i])
                  + gates[:, :, 1] * (y_b @ w_br_b[i])
                  + gates[:, :, 2] * (y_c @ w_br_c[i]))
        x = x + merged @ w_out[i]

        hm = rmsnorm(x, mlp_norm[i])
        x = x + jnp.square(jax.nn.relu(hm @ w_up[i])) @ w_down[i]

        hp = rmsnorm(x, ple_norm[i])
        x = x + jax.nn.sigmoid(hp @ w_ple_gate[i]) * (p[i] @ w_ple_proj[i])
    return x
```

```cpp
#include <hip/hip_runtime.h>
#include <hip/hip_cooperative_groups.h>
#include <cstdio>
#include <cmath>
namespace cg = cooperative_groups;

#ifndef MULTI_LAUNCH
#define MULTI_LAUNCH 0
#endif
#define PROBE_REP 0

typedef unsigned short bf16_t;
typedef _Float16 bf16x8 __attribute__((ext_vector_type(8)));
typedef float f32x4 __attribute__((ext_vector_type(4)));
typedef _Float16 h2_t __attribute__((ext_vector_type(2)));
typedef float f2_t __attribute__((ext_vector_type(2)));
typedef unsigned long long u64;

#define DI __device__ __forceinline__
DI int TIDX() { int t = threadIdx.x; asm volatile("" : "+v"(t)); return t; }
DI int BIDX() { int b = blockIdx.x; asm volatile("" : "+s"(b)); return b; }

constexpr int DM = 1024, NB = 4, SEQ = 4096, NTOK = NB * SEQ, DEPTH = 4, DFF = 4096, PLE = 256;
constexpr int WIN_SRC = 8004, WIN_N = 8064, PW = 6528;
constexpr int C_AQ = 0, C_AK = 512, C_BQ = 1024, C_BK = 1536, C_CQ = 2048, C_CK = 2560, C_IQ = 3072, C_IK = 3328, C_IW = 3392, C_GL = 3456;
constexpr float EPS = 1e-6f;

constexpr size_t WO_IN = 0;
constexpr size_t WO_BRA = WO_IN + (size_t)WIN_N * 1024;
constexpr size_t WO_BRB = WO_BRA + 1024 * 512;
constexpr size_t WO_BRC = WO_BRB + 1024 * 512;
constexpr size_t WO_OUT = WO_BRC + 1024 * 512;
constexpr size_t WO_UP = WO_OUT + 1024 * 1024;
constexpr size_t WO_DOWN = WO_UP + 4096 * 1024;
constexpr size_t WO_GATE = WO_DOWN + 1024 * 4096;
constexpr size_t WO_PP = WO_GATE + 1024 * 1024;
constexpr size_t W_LAYER = WO_PP + 1024 * 256;

constexpr size_t OFF_W = 0;
constexpr size_t OFF_P = OFF_W + W_LAYER * 2 * DEPTH;
constexpr size_t OFF_VT = OFF_P + (size_t)NTOK * PW * 2;
constexpr size_t OFF_XB = OFF_VT + (size_t)3 * NB * 512 * SEQ * 2;
constexpr size_t OFF_MASK = OFF_XB + (size_t)NTOK * DM * 2;
constexpr size_t OFF_COS = OFF_MASK + (size_t)NTOK * 64 * 8;
constexpr size_t OFF_SIN = OFF_COS + (size_t)NTOK * 32 * 4;
constexpr size_t OFF_SSQ = OFF_SIN + (size_t)NTOK * 32 * 4;
constexpr size_t OFF_CTR = OFF_SSQ + (size_t)3 * NTOK * 16 * 4;
constexpr size_t OFF_BAR = OFF_CTR + 4096;
constexpr size_t OFF_PB = OFF_BAR + 16384;
constexpr size_t OFF_XB2 = OFF_PB + (size_t)NTOK * PLE * 2;
constexpr size_t WS_NEED = OFF_XB2 + (size_t)NTOK * DM * 2;
static_assert(WS_NEED <= 524550144ull, "workspace budget");

struct Params {
  const float* x; const float* p; const int* pos;
  const float* attn_norm; const float* w_in; const float* a_q_norm; const float* a_k_norm; const float* a_lambda; const float* a_subln;
  const float* c_q_norm; const float* c_k_norm; const float* idx_k_norm; const float* w_br_a; const float* w_br_b; const float* w_br_c; const float* w_out;
  const float* mlp_norm; const float* w_up; const float* w_down; const float* ple_norm; const float* w_ple_gate; const float* w_ple_proj;
  float* out; char* ws;
  float inv_freq[32]; float lam_init[4];
};

constexpr int SMEM_BYTES = 73728;
constexpr int SMEM_TOTAL = SMEM_BYTES + 64;

DI float bf2f(bf16_t v) { return (float)__builtin_bit_cast(_Float16, v); }
DI unsigned pack2(float lo, float hi) { f2_t v = {lo, hi}; h2_t b = __builtin_convertvector(v, h2_t); return __builtin_bit_cast(unsigned, b); }
DI float lo_f(unsigned u) { return (float)(__builtin_bit_cast(h2_t, u)[0]); }
DI float hi_f(unsigned u) { return (float)(__builtin_bit_cast(h2_t, u)[1]); }
DI float sigmoidf_(float x) { return 1.0f / (1.0f + __expf(-x)); }

struct R2 { uint4 a, b; };
struct R4 { uint4 a, b, c, d; };
constexpr int LROW = 144;
constexpr int LTILE = 128 * 128;
DI uint4 ldA32(const float* pa) { const float4 v0 = *(const float4*)pa, v1 = *(const float4*)(pa + 4); return make_uint4(pack2(v0.x, v0.y), pack2(v0.z, v0.w), pack2(v1.x, v1.y), pack2(v1.z, v1.w)); }
#define PROBE_VAR 0
template <bool AF32, bool SWAP, int NK, int VAR = 0>
DI void gemm_kloop(f32x4 (&acc)[4][4], const void* A_, size_t lda, const bf16_t* Bt, size_t ldb, char* smem) {
  const int tid = TIDX(), lane = tid & 63, wid = tid >> 6, wm = wid >> 1, wn = wid & 1, lr = lane & 15, g = lane >> 4;
  char* sA = smem; char* sB = smem + 2 * LTILE;
  uint4 a00 = {}, a01 = {}, a02 = {}, a03 = {}, b00 = {}, b01 = {}, b02 = {}, b03 = {}, a10 = {}, a11 = {}, a12 = {}, a13 = {}, b10 = {}, b11 = {}, b12 = {}, b13 = {};
  constexpr int nk = NK;
  const int sw0 = (g ^ ((lr >> 1) & 7)) << 4, sw1 = sw0 ^ 64;
  const int r0 = tid >> 3, kc = tid & 7, kcs = kc ^ ((r0 >> 1) & 7);
#define GL_A(i, kt_) (AF32 ? ldA32((const float*)A_ + (size_t)(r0 + 32 * (i)) * lda + (kt_) * 64 + kc * 8) : *(const uint4*)((const bf16_t*)A_ + (size_t)(r0 + 32 * (i)) * lda + (kt_) * 64 + kc * 8))
#define GL_B(i, kt_) (*(const uint4*)(Bt + (size_t)(r0 + 32 * (i)) * ldb + (kt_) * 64 + kc * 8))
#define GL_LOAD(s_, kt_) if (VAR != 1) { a##s_##0 = GL_A(0, kt_); a##s_##1 = GL_A(1, kt_); a##s_##2 = GL_A(2, kt_); a##s_##3 = GL_A(3, kt_); b##s_##0 = GL_B(0, kt_); b##s_##1 = GL_B(1, kt_); b##s_##2 = GL_B(2, kt_); b##s_##3 = GL_B(3, kt_); }
#define LDS_ST1(s_, i, buf_, v) *(uint4*)(s_ + (buf_) * LTILE + (r0 + 32 * (i)) * 128 + kcs * 16) = v;
#define LDS_STORE(s_, buf_) if (VAR != 2) { LDS_ST1(sA, 0, buf_, a##s_##0) LDS_ST1(sA, 1, buf_, a##s_##1) LDS_ST1(sA, 2, buf_, a##s_##2) LDS_ST1(sA, 3, buf_, a##s_##3) LDS_ST1(sB, 0, buf_, b##s_##0) LDS_ST1(sB, 1, buf_, b##s_##1) LDS_ST1(sB, 2, buf_, b##s_##2) LDS_ST1(sB, 3, buf_, b##s_##3) }
#define MMA_TILE(buf_)                                                                                       \
  if (VAR != 3) {                                                                                            \
    const char* pa = sA + (buf_) * LTILE + (wm * 64 + lr) * 128;                                             \
    const char* pb = sB + (buf_) * LTILE + (wn * 64 + lr) * 128;                                             \
    _Pragma("unroll") for (int ks = 0; ks < 2; ++ks) {                                                       \
      bf16x8 af[4], bfr[4];                                                                                  \
      _Pragma("unroll") for (int t = 0; t < 4; ++t) { af[t] = *(const bf16x8*)(pa + t * 16 * 128 + (ks ? sw1 : sw0)); bfr[t] = *(const bf16x8*)(pb + t * 16 * 128 + (ks ? sw1 : sw0)); } \
      _Pragma("unroll") for (int mt = 0; mt < 4; ++mt)                                                       \
        _Pragma("unroll") for (int nt = 0; nt < 4; ++nt)                                                     \
          acc[mt][nt] = SWAP ? __builtin_amdgcn_mfma_f32_16x16x32_f16(bfr[nt], af[mt], acc[mt][nt], 0, 0, 0) \
                             : __builtin_amdgcn_mfma_f32_16x16x32_f16(af[mt], bfr[nt], acc[mt][nt], 0, 0, 0); \
    }                                                                                                        \
  }
  GL_LOAD(0, 0)
  GL_LOAD(1, 1)
  LDS_STORE(0, 0)
  if (VAR != 4) __syncthreads();
#pragma unroll
  for (int kt = 0; kt < nk; kt += 2) {
    if (kt + 2 < nk) { GL_LOAD(0, kt + 2) }
    MMA_TILE(0)
    LDS_STORE(1, 1)
    if (VAR != 4) __syncthreads();
    if (kt + 3 < nk) { GL_LOAD(1, kt + 3) }
    MMA_TILE(1)
    if (kt + 2 < nk) { LDS_STORE(0, 0) }
    if (VAR != 4) __syncthreads();
  }
#undef MMA_TILE
#undef GL_A
#undef GL_B
#undef LDS_ST1
#undef GL_LOAD
#undef LDS_STORE
}

DI void zero_acc(f32x4 (&acc)[4][4]) {
#pragma unroll
  for (int a = 0; a < 4; ++a)
#pragma unroll
    for (int b = 0; b < 4; ++b) acc[a][b] = (f32x4){0.f, 0.f, 0.f, 0.f};
}

DI void load_rstd(float (&rs)[4], const float* ssq, int row0, int lr) {
#pragma unroll
  for (int mt = 0; mt < 4; ++mt) {
    const float4* q = (const float4*)(ssq + (size_t)(row0 + mt * 16 + lr) * 16);
    const float4 a = q[0], b = q[1], c = q[2], d = q[3];
    const float s = ((a.x + a.y) + (a.z + a.w)) + ((b.x + b.y) + (b.z + b.w)) + ((c.x + c.y) + (c.z + c.w)) + ((d.x + d.y) + (d.z + d.w));
    rs[mt] = rsqrtf(s * (1.0f / 1024.0f) + EPS);
  }
}

DI void epi_residual(const f32x4 (&v)[4][4], int row0, int col0, float* x, bf16_t* xb, float* ssq_out, bool write_xb, bool write_ssq) {
  const int lane = TIDX() & 63, lr = lane & 15, g = lane >> 4;
#pragma unroll
  for (int mt = 0; mt < 4; ++mt) {
    const int row = row0 + mt * 16 + lr;
    float ss = 0.f;
#pragma unroll
    for (int nt = 0; nt < 4; ++nt) {
      const int col = col0 + nt * 16 + 4 * g;
      float4* px = (float4*)(x + (size_t)row * DM + col);
      float4 o = *px;
      o.x += v[mt][nt][0]; o.y += v[mt][nt][1]; o.z += v[mt][nt][2]; o.w += v[mt][nt][3];
      *px = o;
      ss += (o.x * o.x + o.y * o.y) + (o.z * o.z + o.w * o.w);
      if (write_xb) *(uint2*)(xb + (size_t)row * DM + col) = make_uint2(pack2(o.x, o.y), pack2(o.z, o.w));
    }
    if (write_ssq) {
      ss += __shfl_xor(ss, 16); ss += __shfl_xor(ss, 32);
      if (g == 0) ssq_out[(size_t)row * 16 + (col0 >> 6)] = ss;
    }
  }
}


DI bool tile_of(int vb, int MT, int NT, int& m, int& n) {
  const int ngrp_n = (NT + 7) >> 3;
  const int grp = vb >> 9, b = vb & 511;
  const int mh = grp / ngrp_n, ng = grp - mh * ngrp_n;
  const int xcd = b & 7, j = b >> 3;
  m = mh * 64 + xcd * 8 + (j & 7);
  n = ng * 8 + (j >> 3);
  return m < MT && n < NT;
}
DI int tile_groups(int MT, int NT) { return (MT >> 6) * ((NT + 7) >> 3) * 512; }

DI int map_in(int n) {
  if (n < 1024) return n;
  if (n < 2048) return n + 512;
  if (n < 3072) return n + 1024;
  if (n < 3396) return n + 1536;
  if (n < 3456) return -1;
  if (n < 6528) return n - 3456 + 4932;
  if (n < 7040) return n - 6528 + 1024;
  if (n < 7552) return n - 7040 + 2560;
  return n - 7552 + 4096;
}

DI void convert_w(const float* src, bf16_t* dst, int K, int Nsrc, int Ndst, const float* gain, bool mapin, char* smem, int& tile_base) {
  float* t = (float*)smem;
  const int tid = TIDX();
  const int tk = K >> 6, tn = Ndst >> 6, ntile = tk * tn;
  int first = (int)BIDX() - (tile_base % (int)gridDim.x); if (first < 0) first += gridDim.x;
  const int tx = tid & 15, ty = tid >> 4;
  for (int tt = first; tt < ntile; tt += 4 * gridDim.x) {
    float4 v[4][4];
#pragma unroll
    for (int u = 0; u < 4; ++u) {
      const int tu = tt + u * (int)gridDim.x;
      if (tu < ntile) {
        const int k0 = (tu % tk) * 64, n0 = (tu / tk) * 64;
        const int n = n0 + 4 * tx; const int ns = mapin ? map_in(n) : n;
#pragma unroll
        for (int i = 0; i < 4; ++i) {
          const int kk = ty + 16 * i;
          v[u][i] = make_float4(0.f, 0.f, 0.f, 0.f);
          if (ns >= 0) { v[u][i] = *(const float4*)(src + (size_t)(k0 + kk) * Nsrc + ns); if (gain) { const float gk = gain[k0 + kk]; v[u][i].x *= gk; v[u][i].y *= gk; v[u][i].z *= gk; v[u][i].w *= gk; } }
        }
      }
    }
    __syncthreads();
#pragma unroll
    for (int u = 0; u < 4; ++u) {
      if (tt + u * (int)gridDim.x < ntile) {
        float* tb = t + u * (64 * 65);
#pragma unroll
        for (int i = 0; i < 4; ++i) { const int kk = ty + 16 * i; tb[kk * 65 + 4 * tx] = v[u][i].x; tb[kk * 65 + 4 * tx + 1] = v[u][i].y; tb[kk * 65 + 4 * tx + 2] = v[u][i].z; tb[kk * 65 + 4 * tx + 3] = v[u][i].w; }
      }
    }
    __syncthreads();
#pragma unroll
    for (int u = 0; u < 4; ++u) {
      const int tu = tt + u * (int)gridDim.x;
      if (tu < ntile) {
        const int k0 = (tu % tk) * 64, n0 = (tu / tk) * 64;
        const float* tb = t + u * (64 * 65);
        const int n = tid >> 2, kq = tid & 3;
        unsigned w[8];
#pragma unroll
        for (int e = 0; e < 8; ++e) w[e] = pack2(tb[(kq * 16 + 2 * e) * 65 + n], tb[(kq * 16 + 2 * e + 1) * 65 + n]);
        uint4* d = (uint4*)(dst + (size_t)(n0 + n) * K + k0 + kq * 16);
        d[0] = make_uint4(w[0], w[1], w[2], w[3]); d[1] = make_uint4(w[4], w[5], w[6], w[7]);
      }
    }
  }
  tile_base += ntile;
}

DI void phase0(const Params& P, char* smem) {
  char* ws = P.ws;
  int tb = 0;
  for (int l = 0; l < DEPTH; ++l) {
    bf16_t* W = (bf16_t*)(ws + OFF_W) + (size_t)l * W_LAYER;
    convert_w(P.w_in + (size_t)l * 1024 * WIN_SRC, W + WO_IN, 1024, WIN_SRC, WIN_N, P.attn_norm + l * 1024, true, smem, tb);
    convert_w(P.w_br_a + (size_t)l * 512 * 1024, W + WO_BRA, 512, 1024, 1024, nullptr, false, smem, tb);
    convert_w(P.w_br_b + (size_t)l * 512 * 1024, W + WO_BRB, 512, 1024, 1024, nullptr, false, smem, tb);
    convert_w(P.w_br_c + (size_t)l * 512 * 1024, W + WO_BRC, 512, 1024, 1024, nullptr, false, smem, tb);
    convert_w(P.w_out + (size_t)l * 1024 * 1024, W + WO_OUT, 1024, 1024, 1024, nullptr, false, smem, tb);
    convert_w(P.w_up + (size_t)l * 1024 * 4096, W + WO_UP, 1024, 4096, 4096, P.mlp_norm + l * 1024, false, smem, tb);
    convert_w(P.w_down + (size_t)l * 4096 * 1024, W + WO_DOWN, 4096, 1024, 1024, nullptr, false, smem, tb);
    convert_w(P.w_ple_gate + (size_t)l * 1024 * 1024, W + WO_GATE, 1024, 1024, 1024, P.ple_norm + l * 1024, false, smem, tb);
    convert_w(P.w_ple_proj + (size_t)l * 256 * 1024, W + WO_PP, 256, 1024, 1024, nullptr, false, smem, tb);
  }
  const int gtid = BIDX() * 256 + TIDX(), gsz = gridDim.x * 256;
  float* cs = (float*)(ws + OFF_COS); float* sn = (float*)(ws + OFF_SIN);
  for (int i = gtid; i < NTOK * 32; i += gsz) {
    const int tok = i >> 5, f = i & 31;
    const float angf = (float)P.pos[tok] * P.inv_freq[f];
    const double a = (double)angf;
    const double k = rint(a * 0.15915494309189535);
    const float r = (float)(a - k * 6.283185307179586);
    cs[i] = __cosf(r); sn[i] = __sinf(r);
  }
  float* ssq = (float*)(ws + OFF_SSQ);
  bf16_t* xb = (bf16_t*)(ws + OFF_XB2);
  const int lane = TIDX() & 63, gw = gtid >> 6, nw = gsz >> 6;
  for (int row0 = gw; row0 < NTOK; row0 += 4 * nw) {
    float4 v[4][4];
#pragma unroll
    for (int u = 0; u < 4; ++u) {
      const int row = row0 + u * nw;
      if (row < NTOK) {
#pragma unroll
        for (int i = 0; i < 4; ++i) v[u][i] = ((const float4*)(P.x + (size_t)row * DM))[lane + 64 * i];
      }
    }
#pragma unroll
    for (int u = 0; u < 4; ++u) {
      const int row = row0 + u * nw;
      if (row < NTOK) {
        float ss = 0.f;
#pragma unroll
        for (int i = 0; i < 4; ++i) {
          const float4 w = v[u][i];
          ss += (w.x * w.x + w.y * w.y) + (w.z * w.z + w.w * w.w);
          ((float4*)(P.out + (size_t)row * DM))[lane + 64 * i] = w;
          ((uint2*)(xb + (size_t)row * DM))[lane + 64 * i] = make_uint2(pack2(w.x, w.y), pack2(w.z, w.w));
        }
#pragma unroll
        for (int o = 32; o > 0; o >>= 1) ss += __shfl_xor(ss, o);
        if (lane < 16) ssq[(size_t)row * 16 + lane] = lane == 0 ? ss : 0.f;
      }
    }
  }
}


DI void phase_proj(const Params& P, int l, char* smem) {
  char* ws = P.ws;
  const bf16_t* xb = (const bf16_t*)(ws + OFF_XB2);
  const bf16_t* Wt = (const bf16_t*)(ws + OFF_W) + (size_t)l * W_LAYER + WO_IN;
  bf16_t* Pb = (bf16_t*)(ws + OFF_P);
  bf16_t* VT = (bf16_t*)(ws + OFF_VT);
  const float* ssq = (const float*)(ws + OFF_SSQ);
  const float* cs = (const float*)(ws + OFF_COS); const float* sn = (const float*)(ws + OFF_SIN);
  const int tid = TIDX(), lane = tid & 63, wid = tid >> 6, wm = wid >> 1, wn = wid & 1, lr = lane & 15, g = lane >> 4;
  for (int vb = BIDX(); vb < tile_groups(128, 63); vb += gridDim.x) {
    int tm, tn; if (!tile_of(vb, 128, 63, tm, tn)) continue;
    const int m0 = tm * 128, n0 = tn * 128;
    f32x4 acc[4][4]; zero_acc(acc);
    const int row0 = m0 + wm * 64, col0 = n0 + wn * 64;
    float rs[4]; load_rstd(rs, ssq, row0, lr);
    if (n0 >= PW) {
      gemm_kloop<false, false, 16>(acc, xb + (size_t)m0 * DM, DM, Wt + (size_t)n0 * DM, DM, smem);
      const int cb = col0 - PW;
      const int br = cb >> 9, c0 = cb & 511;
      const int b = row0 >> 12, s0 = row0 & 4095;
#pragma unroll
      for (int mt = 0; mt < 4; ++mt) {
        float r4[4];
#pragma unroll
        for (int j = 0; j < 4; ++j) r4[j] = __shfl(rs[mt], 4 * g + j);
#pragma unroll
        for (int nt = 0; nt < 4; ++nt) {
          const int c = c0 + nt * 16 + lr;
          bf16_t* dst = VT + ((size_t)(br * NB + b) * 512 + c) * SEQ + s0 + mt * 16 + 4 * g;
          *(uint2*)dst = make_uint2(pack2(acc[mt][nt][0] * r4[0], acc[mt][nt][1] * r4[1]), pack2(acc[mt][nt][2] * r4[2], acc[mt][nt][3] * r4[3]));
        }
      }
    } else {
      gemm_kloop<false, true, 16>(acc, xb + (size_t)m0 * DM, DM, Wt + (size_t)n0 * DM, DM, smem);
#pragma unroll
      for (int mt = 0; mt < 4; ++mt)
#pragma unroll
        for (int nt = 0; nt < 4; ++nt) acc[mt][nt] *= rs[mt];
      const float* gain = nullptr; bool rope = false; float sc = 1.f; bool sig = false;
      constexpr float QS = 0.125f * 1.4426950408889634f;
      if (col0 < C_AK) { gain = P.a_q_norm + l * 64; rope = true; sc = QS; }
      else if (col0 < C_BQ) { gain = P.a_k_norm + l * 64; rope = true; }
      else if (col0 < C_BK) { sc = QS; }
      else if (col0 < C_CQ) { }
      else if (col0 < C_CK) { gain = P.c_q_norm + l * 64; rope = true; sc = QS; }
      else if (col0 < C_IQ) { gain = P.c_k_norm + l * 64; rope = true; }
      else if (col0 < C_IK) { rope = true; sc = 0.125f; }
      else if (col0 < C_IW) { gain = P.idx_k_norm + l * 64; rope = true; }
      else if (col0 < C_GL) { sc = 0.5f; }
      else { sig = true; }
      if (gain) {
        float gv[4][4];
#pragma unroll
        for (int nt = 0; nt < 4; ++nt) { const float4 q = *(const float4*)(gain + nt * 16 + 4 * g); gv[nt][0] = q.x; gv[nt][1] = q.y; gv[nt][2] = q.z; gv[nt][3] = q.w; }
#pragma unroll
        for (int mt = 0; mt < 4; ++mt) {
          float ss = 0.f;
#pragma unroll
          for (int nt = 0; nt < 4; ++nt)
#pragma unroll
            for (int j = 0; j < 4; ++j) ss += acc[mt][nt][j] * acc[mt][nt][j];
          ss += __shfl_xor(ss, 16); ss += __shfl_xor(ss, 32);
          const float r = rsqrtf(ss * (1.0f / 64.0f) + EPS);
#pragma unroll
          for (int nt = 0; nt < 4; ++nt)
#pragma unroll
            for (int j = 0; j < 4; ++j) acc[mt][nt][j] *= r * gv[nt][j];
        }
      }
      if (rope) {
#pragma unroll
        for (int mt = 0; mt < 4; ++mt) {
          const int row = row0 + mt * 16 + lr;
#pragma unroll
          for (int h = 0; h < 2; ++h) {
            const float4 c4 = *(const float4*)(cs + (size_t)row * 32 + h * 16 + 4 * g);
            const float4 s4 = *(const float4*)(sn + (size_t)row * 32 + h * 16 + 4 * g);
            const float cc[4] = {c4.x, c4.y, c4.z, c4.w}, ssn[4] = {s4.x, s4.y, s4.z, s4.w};
#pragma unroll
            for (int j = 0; j < 4; ++j) {
              const float x1 = acc[mt][h][j], x2 = acc[mt][h + 2][j];
              acc[mt][h][j] = x1 * cc[j] - x2 * ssn[j];
              acc[mt][h + 2][j] = x2 * cc[j] + x1 * ssn[j];
            }
          }
        }
      }
#pragma unroll
      for (int mt = 0; mt < 4; ++mt) {
        const int row = row0 + mt * 16 + lr;
#pragma unroll
        for (int nt = 0; nt < 4; ++nt) {
          f32x4 v = acc[mt][nt] * sc;
          if (sig) { v[0] = sigmoidf_(v[0]); v[1] = sigmoidf_(v[1]); v[2] = sigmoidf_(v[2]); v[3] = sigmoidf_(v[3]); }
          *(uint2*)(Pb + (size_t)row * PW + col0 + nt * 16 + 4 * g) = make_uint2(pack2(v[0], v[1]), pack2(v[2], v[3]));
        }
      }
    }
  }
}

DI int next_item(unsigned* ctr, char* smem) {
  int* s = (int*)(smem + SMEM_BYTES);
  __syncthreads();
  if (TIDX() == 0) *s = (int)atomicAdd(ctr, 1u);
  __syncthreads();
  const int v = *s;
  return v;
}

DI float compute_lam(const Params& P, int l) {
  const int lane = TIDX() & 63;
  const float* lp = P.a_lambda + l * 256;
  float a = lp[lane] * lp[64 + lane], b = lp[128 + lane] * lp[192 + lane];
#pragma unroll
  for (int o = 32; o > 0; o >>= 1) { a += __shfl_xor(a, o); b += __shfl_xor(b, o); }
  return __expf(a) - __expf(b) + P.lam_init[l];
}

#define MFMA16(a, b, c) __builtin_amdgcn_mfma_f32_16x16x32_f16((a), (b), (c), 0, 0, 0)
DI bf16x8 pack8(const f32x4& a, const f32x4& b) {
  const uint4 u = make_uint4(pack2(a[0], a[1]), pack2(a[2], a[3]), pack2(b[0], b[1]), pack2(b[2], b[3]));
  return __builtin_bit_cast(bf16x8, u);
}
DI bf16x8 vfrag(const char* sV, int dt, int kk, int lr, int g) {
  return *(const bf16x8*)(sV + (dt * 16 + lr) * 128 + (((kk * 4 + g) ^ ((lr >> 1) & 7)) << 4));
}
DI uint4 ld_chunk(const bf16_t* gsrc, size_t gp, int c) { return *(const uint4*)(gsrc + (size_t)(c >> 3) * gp + (c & 7) * 8); }
DI void st_chunk_k(char* sdst, int c, const uint4& v) { const int row = c >> 3; *(uint4*)(sdst + row * 128 + (((c & 7) ^ ((row >> 1) & 7)) << 4)) = v; }
DI void st_chunk_v(char* sdst, int c, const uint4& v) {
  const int row = c >> 3, c8 = c & 7, kk = c8 >> 2, cc = c8 & 3, sw = (row >> 1) & 7;
  const int gq = (cc & 1) * 2, part = cc >> 1;
  char* base = sdst + row * 128 + part * 8;
  *(uint2*)(base + (((kk * 4 + gq) ^ sw) << 4)) = make_uint2(v.x, v.y);
  *(uint2*)(base + (((kk * 4 + gq + 1) ^ sw) << 4)) = make_uint2(v.z, v.w);
}
DI void gload2(R2& r, const bf16_t* gsrc, size_t gp, int tid) { r.a = ld_chunk(gsrc, gp, tid); r.b = ld_chunk(gsrc, gp, tid + 256); }
DI void gload4(R4& r, const bf16_t* gsrc, size_t gp, int tid) { r.a = ld_chunk(gsrc, gp, tid); r.b = ld_chunk(gsrc, gp, tid + 256); r.c = ld_chunk(gsrc, gp, tid + 512); r.d = ld_chunk(gsrc, gp, tid + 768); }
DI void sstoreK2(const R2& r, char* sdst, int tid) { st_chunk_k(sdst, tid, r.a); st_chunk_k(sdst, tid + 256, r.b); }
DI void sstoreV2(const R2& r, char* sdst, int tid) { st_chunk_v(sdst, tid, r.a); st_chunk_v(sdst, tid + 256, r.b); }
DI void sstoreV4(const R4& r, char* sdst, int tid) { st_chunk_v(sdst, tid, r.a); st_chunk_v(sdst, tid + 256, r.b); st_chunk_v(sdst, tid + 512, r.c); st_chunk_v(sdst, tid + 768, r.d); }
DI void qk_tile(f32x4 (&st)[4], const char* sK, const bf16x8 (&qf)[2], int lr, int g) {
#pragma unroll
  for (int kt = 0; kt < 4; ++kt) {
    st[kt] = (f32x4){0.f, 0.f, 0.f, 0.f};
#pragma unroll
    for (int ks = 0; ks < 2; ++ks) st[kt] = MFMA16(*(const bf16x8*)(sK + (kt * 16 + lr) * 128 + (((ks * 4 + g) ^ ((lr >> 1) & 7)) << 4)), qf[ks], st[kt]);
  }
}
DI void qk_tile2(f32x4 (&sa)[4], f32x4 (&sb)[4], const char* sK, const bf16x8 (&qa)[2], const bf16x8 (&qb)[2], int lr, int g) {
#pragma unroll
  for (int kt = 0; kt < 4; ++kt) {
    const bf16x8 k0 = *(const bf16x8*)(sK + (kt * 16 + lr) * 128 + ((g ^ ((lr >> 1) & 7)) << 4)), k1 = *(const bf16x8*)(sK + (kt * 16 + lr) * 128 + (((4 + g) ^ ((lr >> 1) & 7)) << 4));
    sa[kt] = MFMA16(k0, qa[0], ((f32x4){0.f, 0.f, 0.f, 0.f})); sb[kt] = MFMA16(k0, qb[0], ((f32x4){0.f, 0.f, 0.f, 0.f}));
    sa[kt] = MFMA16(k1, qa[1], sa[kt]); sb[kt] = MFMA16(k1, qb[1], sb[kt]);
  }
}
DI float softmax_step(f32x4 (&st)[4], float& m, float& lsum) {
  float mx = fmaxf(fmaxf(fmaxf(st[0][0], st[0][1]), fmaxf(st[0][2], st[0][3])), fmaxf(fmaxf(st[1][0], st[1][1]), fmaxf(st[1][2], st[1][3])));
  mx = fmaxf(mx, fmaxf(fmaxf(fmaxf(st[2][0], st[2][1]), fmaxf(st[2][2], st[2][3])), fmaxf(fmaxf(st[3][0], st[3][1]), fmaxf(st[3][2], st[3][3]))));
  mx = fmaxf(mx, __shfl_xor(mx, 16)); mx = fmaxf(mx, __shfl_xor(mx, 32));
  const float mn = fmaxf(m, mx);
  const float mu = mn == -INFINITY ? 0.f : mn;
  const float alpha = __builtin_amdgcn_exp2f(m - mu);
  float ps = 0.f;
#pragma unroll
  for (int kt = 0; kt < 4; ++kt)
#pragma unroll
    for (int j = 0; j < 4; ++j) { const float p = __builtin_amdgcn_exp2f(st[kt][j] - mu); st[kt][j] = p; ps += p; }
  lsum = lsum * alpha + ps; m = mn;
  return alpha;
}

DI void attn_A(const Params& P, int l, int b, int head, int qt, float lam, char* smem, bf16_t* ybase, size_t ypitch) {
  char* ws = P.ws;
  bf16_t* Pb = (bf16_t*)(ws + OFF_P);
  const bf16_t* VT = (const bf16_t*)(ws + OFF_VT);
  const int tid = TIDX(), lane = tid & 63, wid = tid >> 6, lr = lane & 15, g = lane >> 4;
  const size_t tokq = (size_t)b * SEQ + qt * 64 + wid * 16 + lr;
  bf16x8 qf0[2], qf1[2];
#pragma unroll
  for (int ks = 0; ks < 2; ++ks) {
    qf0[ks] = *(const bf16x8*)(Pb + tokq * PW + C_AQ + head * 128 + ks * 32 + 8 * g);
    qf1[ks] = *(const bf16x8*)(Pb + tokq * PW + C_AQ + head * 128 + 64 + ks * 32 + 8 * g);
  }
  f32x4 o0[8], o1[8];
#pragma unroll
  for (int i = 0; i < 8; ++i) { o0[i] = (f32x4){0.f, 0.f, 0.f, 0.f}; o1[i] = (f32x4){0.f, 0.f, 0.f, 0.f}; }
  float m0 = -INFINITY, m1 = -INFINITY, l0 = 0.f, l1 = 0.f;
  const bf16_t* kbase = Pb + (size_t)b * SEQ * PW + C_AK + head * 128;
  const bf16_t* vbase = VT + ((size_t)(0 * NB + b) * 512 + head * 128) * SEQ;
  constexpr int STAGE = 2 * 9216 + 18432;
  R2 rk0, rk1; R4 rv;
  gload2(rk0, kbase, PW, tid); gload2(rk1, kbase + 64, PW, tid); gload4(rv, vbase, SEQ, tid);
  sstoreK2(rk0, smem, tid); sstoreK2(rk1, smem + 9216, tid); sstoreV4(rv, smem + 18432, tid);
  __syncthreads();
  for (int n = 0; n <= qt; ++n) {
    const char* sb = smem + (n & 1) * STAGE;
    if (n < qt) {
      const bf16_t* kn = kbase + (size_t)(n + 1) * 64 * PW;
      gload2(rk0, kn, PW, tid); gload2(rk1, kn + 64, PW, tid); gload4(rv, vbase + (n + 1) * 64, SEQ, tid);
    }
    f32x4 s0[4], s1[4];
    qk_tile(s0, sb, qf0, lr, g);
    qk_tile(s1, sb + 9216, qf1, lr, g);
    const float a0 = softmax_step(s0, m0, l0), a1 = softmax_step(s1, m1, l1);
#pragma unroll
    for (int i = 0; i < 8; ++i) { o0[i] *= a0; o1[i] *= a1; }
#pragma unroll
    for (int kk = 0; kk < 2; ++kk) {
      const bf16x8 p0 = pack8(s0[2 * kk], s0[2 * kk + 1]), p1 = pack8(s1[2 * kk], s1[2 * kk + 1]);
#pragma unroll
      for (int dt = 0; dt < 8; ++dt) {
        const bf16x8 vf = vfrag(sb + 18432, dt, kk, lr, g);
        o0[dt] = MFMA16(vf, p0, o0[dt]);
        o1[dt] = MFMA16(vf, p1, o1[dt]);
      }
    }
    if (n < qt) {
      char* sn = smem + ((n + 1) & 1) * STAGE;
      sstoreK2(rk0, sn, tid); sstoreK2(rk1, sn + 9216, tid); sstoreV4(rv, sn + 18432, tid);
    }
    __syncthreads();
  }
  l0 += __shfl_xor(l0, 16); l0 += __shfl_xor(l0, 32);
  l1 += __shfl_xor(l1, 16); l1 += __shfl_xor(l1, 32);
  const float i0 = 1.0f / l0, i1 = lam / l1;
  float ss = 0.f;
#pragma unroll
  for (int dt = 0; dt < 8; ++dt)
#pragma unroll
    for (int j = 0; j < 4; ++j) { const float v = o0[dt][j] * i0 - o1[dt][j] * i1; o0[dt][j] = v; ss += v * v; }
  ss += __shfl_xor(ss, 16); ss += __shfl_xor(ss, 32);
  const float r = rsqrtf(ss * (1.0f / 128.0f) + EPS) * (1.0f - P.lam_init[l]);
  const float* sg = P.a_subln + l * 128;
  bf16_t* yp = ybase + tokq * ypitch + head * 128;
#pragma unroll
  for (int dt = 0; dt < 8; ++dt) {
    const float4 gq = *(const float4*)(sg + dt * 16 + 4 * g);
    *(uint2*)(yp + dt * 16 + 4 * g) = make_uint2(pack2(o0[dt][0] * r * gq.x, o0[dt][1] * r * gq.y), pack2(o0[dt][2] * r * gq.z, o0[dt][3] * r * gq.w));
  }
}

DI void attn_B(const Params& P, int b, int head, int qt, char* smem, bf16_t* ybase, size_t ypitch) {
  char* ws = P.ws;
  bf16_t* Pb = (bf16_t*)(ws + OFF_P);
  const bf16_t* VT = (const bf16_t*)(ws + OFF_VT);
  const int tid = TIDX(), lane = tid & 63, wid = tid >> 6, lr = lane & 15, g = lane >> 4;
  const size_t tokq = (size_t)b * SEQ + qt * 64 + wid * 16 + lr;
  bf16x8 qf[2];
#pragma unroll
  for (int ks = 0; ks < 2; ++ks) qf[ks] = *(const bf16x8*)(Pb + tokq * PW + C_BQ + head * 64 + ks * 32 + 8 * g);
  f32x4 o[4];
#pragma unroll
  for (int i = 0; i < 4; ++i) o[i] = (f32x4){0.f, 0.f, 0.f, 0.f};
  float R = 1.0f;
  const bf16_t* kbase = Pb + (size_t)b * SEQ * PW + C_BK + head * 64;
  const bf16_t* vbase = VT + ((size_t)(1 * NB + b) * 512 + head * 64) * SEQ;
  constexpr int STAGE = 2 * 9216;
  R2 rk, rv;
  gload2(rk, kbase + (size_t)qt * 64 * PW, PW, tid); gload2(rv, vbase + qt * 64, SEQ, tid);
  sstoreK2(rk, smem, tid); sstoreV2(rv, smem + 9216, tid);
  __syncthreads();
  const int ql = wid * 16 + lr;
  for (int n = qt; n >= 0; --n) {
    const int it = qt - n;
    const char* sb = smem + (it & 1) * STAGE;
    if (n > 0) { gload2(rk, kbase + (size_t)(n - 1) * 64 * PW, PW, tid); gload2(rv, vbase + (n - 1) * 64, SEQ, tid); }
    f32x4 st[4];
    qk_tile(st, sb, qf, lr, g);
    float T[4];
#pragma unroll
    for (int kt = 0; kt < 4; ++kt) {
      float be[4], om[4];
#pragma unroll
      for (int j = 0; j < 4; ++j) {
        const float z = fmaxf(st[kt][j], -43.28f);
        const float e = __builtin_amdgcn_exp2f(-z), rr = 1.0f / (1.0f + e);
        const bool ok = (n < qt) || (kt * 16 + 4 * g + j < ql);
        be[j] = ok ? rr : 0.f; om[j] = ok ? e * rr : 1.0f;
      }
      const float c2 = om[3], c1 = c2 * om[2], c0 = c1 * om[1], tot = c0 * om[0];
      const float t1 = __shfl_xor(tot, 16), t2 = __shfl_xor(tot, 32), t3 = __shfl_xor(t1, 32);
      const float G = g == 0 ? t1 * t2 * t3 : (g == 1 ? t2 * t3 : (g == 2 ? t1 : 1.0f));
      T[kt] = (tot * t1) * (t2 * t3);
      st[kt][0] = be[0] * c0 * G; st[kt][1] = be[1] * c1 * G; st[kt][2] = be[2] * c2 * G; st[kt][3] = be[3] * G;
    }
    const float H2 = T[3] * R, H1 = T[2] * H2, H0 = T[1] * H1;
    st[0] *= H0; st[1] *= H1; st[2] *= H2; st[3] *= R;
    R = T[0] * H0;
#pragma unroll
    for (int kk = 0; kk < 2; ++kk) {
      const bf16x8 pk = pack8(st[2 * kk], st[2 * kk + 1]);
#pragma unroll
      for (int dt = 0; dt < 4; ++dt) o[dt] = MFMA16(vfrag(sb + 9216, dt, kk, lr, g), pk, o[dt]);
    }
    if (n > 0) { char* sn = smem + ((it + 1) & 1) * STAGE; sstoreK2(rk, sn, tid); sstoreV2(rv, sn + 9216, tid); }
    if (!__syncthreads_or(R != 0.f)) break;
  }
  bf16_t* yp = ybase + tokq * ypitch + head * 64;
#pragma unroll
  for (int dt = 0; dt < 4; ++dt) *(uint2*)(yp + dt * 16 + 4 * g) = make_uint2(pack2(o[dt][0], o[dt][1]), pack2(o[dt][2], o[dt][3]));
}

DI unsigned sortable(float f) { const unsigned u = __float_as_uint(f); return (u & 0x80000000u) ? ~u : (u | 0x80000000u); }

DI void attn_C2x(const Params& P, int b, int head, int qp, char* smem, bf16_t* ybase, size_t ypitch) {
  char* ws = P.ws;
  bf16_t* Pb = (bf16_t*)(ws + OFF_P);
  const bf16_t* VT = (const bf16_t*)(ws + OFF_VT);
  const uint2* mask = (const uint2*)(ws + OFF_MASK);
  const int tid = TIDX(), lane = tid & 63, wid = tid >> 6, lr = lane & 15, g = lane >> 4;
  const int myc = 2 * qp + (wid >> 1);
  const size_t tok0 = (size_t)b * SEQ + qp * 128 + wid * 32 + lr;
  bf16x8 qfa[2], qfb[2];
#pragma unroll
  for (int ks = 0; ks < 2; ++ks) {
    qfa[ks] = *(const bf16x8*)(Pb + tok0 * PW + C_CQ + head * 64 + ks * 32 + 8 * g);
    qfb[ks] = *(const bf16x8*)(Pb + (tok0 + 16) * PW + C_CQ + head * 64 + ks * 32 + 8 * g);
  }
  f32x4 oa[4], ob[4];
#pragma unroll
  for (int i = 0; i < 4; ++i) { oa[i] = (f32x4){0.f, 0.f, 0.f, 0.f}; ob[i] = (f32x4){0.f, 0.f, 0.f, 0.f}; }
  float ma = -INFINITY, mb = -INFINITY, la = 0.f, lb = 0.f;
  const bf16_t* kbase = Pb + (size_t)b * SEQ * PW + C_CK + head * 64;
  const bf16_t* vbase = VT + ((size_t)(2 * NB + b) * 512 + head * 64) * SEQ;
  constexpr int STAGE = 2 * 9216;
  const int nlast = 2 * qp + 1;
#define C2X_COMPUTE(n_, sb_)                                                                                         \
  if ((n_) <= myc) {                                                                                                 \
    const uint2 mwa = mask[tok0 * 64 + (n_)], mwb = mask[(tok0 + 16) * 64 + (n_)];                                   \
    f32x4 sa[4], sbb[4];                                                                                             \
    qk_tile2(sa, sbb, (sb_), qfa, qfb, lr, g);                                                                       \
    _Pragma("unroll") for (int kt = 0; kt < 4; ++kt) {                                                               \
      const unsigned ba = ((kt < 2 ? mwa.x : mwa.y) >> ((kt & 1) * 16 + 4 * g)) & 0xFu;                              \
      const unsigned bb = ((kt < 2 ? mwb.x : mwb.y) >> ((kt & 1) * 16 + 4 * g)) & 0xFu;                              \
      _Pragma("unroll") for (int j = 0; j < 4; ++j) {                                                                \
        sa[kt][j] = ((ba >> j) & 1u) ? sa[kt][j] : -INFINITY;                                                        \
        sbb[kt][j] = ((bb >> j) & 1u) ? sbb[kt][j] : -INFINITY;                                                      \
      }                                                                                                              \
    }                                                                                                                \
    const float ala = softmax_step(sa, ma, la), alb = softmax_step(sbb, mb, lb);                                     \
    _Pragma("unroll") for (int i = 0; i < 4; ++i) { oa[i] *= ala; ob[i] *= alb; }                                    \
    _Pragma("unroll") for (int kk = 0; kk < 2; ++kk) {                                                               \
      const bf16x8 pa = pack8(sa[2 * kk], sa[2 * kk + 1]), pb = pack8(sbb[2 * kk], sbb[2 * kk + 1]);                 \
      _Pragma("unroll") for (int dt = 0; dt < 4; ++dt) {                                                             \
        const bf16x8 vf = vfrag((sb_) + 9216, dt, kk, lr, g);                                                        \
        oa[dt] = MFMA16(vf, pa, oa[dt]);                                                                             \
        ob[dt] = MFMA16(vf, pb, ob[dt]);                                                                             \
      }                                                                                                              \
    }                                                                                                                \
  }
  R2 rk0, rv0, rk1, rv1;
  gload2(rk0, kbase, PW, tid); gload2(rv0, vbase, SEQ, tid);
  gload2(rk1, kbase + (size_t)64 * PW, PW, tid); gload2(rv1, vbase + 64, SEQ, tid);
  sstoreK2(rk0, smem, tid); sstoreV2(rv0, smem + 9216, tid);
  __syncthreads();
  for (int n = 0; n <= nlast; n += 2) {
    if (n + 2 <= nlast) { gload2(rk0, kbase + (size_t)(n + 2) * 64 * PW, PW, tid); gload2(rv0, vbase + (n + 2) * 64, SEQ, tid); }
    C2X_COMPUTE(n, smem)
    sstoreK2(rk1, smem + STAGE, tid); sstoreV2(rv1, smem + STAGE + 9216, tid);
    __syncthreads();
    if (n + 3 <= nlast) { gload2(rk1, kbase + (size_t)(n + 3) * 64 * PW, PW, tid); gload2(rv1, vbase + (n + 3) * 64, SEQ, tid); }
    C2X_COMPUTE(n + 1, smem + STAGE)
    if (n + 2 <= nlast) { sstoreK2(rk0, smem, tid); sstoreV2(rv0, smem + 9216, tid); }
    __syncthreads();
  }
#undef C2X_COMPUTE
  la += __shfl_xor(la, 16); la += __shfl_xor(la, 32);
  lb += __shfl_xor(lb, 16); lb += __shfl_xor(lb, 32);
  const float ia = 1.0f / la, ib = 1.0f / lb;
  bf16_t* ypa = ybase + tok0 * ypitch + head * 64;
  bf16_t* ypb = ybase + (tok0 + 16) * ypitch + head * 64;
#pragma unroll
  for (int dt = 0; dt < 4; ++dt) {
    *(uint2*)(ypa + dt * 16 + 4 * g) = make_uint2(pack2(oa[dt][0] * ia, oa[dt][1] * ia), pack2(oa[dt][2] * ia, oa[dt][3] * ia));
    *(uint2*)(ypb + dt * 16 + 4 * g) = make_uint2(pack2(ob[dt][0] * ib, ob[dt][1] * ib), pack2(ob[dt][2] * ib, ob[dt][3] * ib));
  }
}

constexpr int C1_HP = 1028;
template <int MODE>
DI void c1_pass(const bf16_t* kbase, int ntile, int wid, int lr, int g, const bf16x8 (&qf)[4][2], const float (&w)[4][4],
                const unsigned (&pfx)[4], const unsigned (&need)[4], unsigned himask, int shift, unsigned bmask, bool any_tie,
                unsigned* hist, unsigned short* cnt, u64* mrow) {
  bf16x8 kf[4][2], kn[4][2];
  if (wid < ntile) {
#pragma unroll
    for (int kt = 0; kt < 4; ++kt)
#pragma unroll
      for (int ks = 0; ks < 2; ++ks) kf[kt][ks] = *(const bf16x8*)(kbase + (size_t)(wid * 64 + kt * 16) * PW + ks * 32);
  }
#pragma unroll 1
  for (int n = wid; n < ntile; n += 4) {
    {
      const int nn = n + 4 < ntile ? n + 4 : n;
#pragma unroll
      for (int kt = 0; kt < 4; ++kt)
#pragma unroll
        for (int ks = 0; ks < 2; ++ks) kn[kt][ks] = *(const bf16x8*)(kbase + (size_t)(nn * 64 + kt * 16) * PW + ks * 32);
    }
    unsigned base[4] = {0u, 0u, 0u, 0u};
    u64 word[4] = {0ull, 0ull, 0ull, 0ull};
    u64 zword[4] = {0ull, 0ull, 0ull, 0ull};
    if (MODE == 2 && any_tie) {
#pragma unroll
      for (int j = 0; j < 4; ++j) base[j] = cnt[(4 * g + j) * 64 + n];
    }
#pragma unroll
    for (int kt = 0; kt < 4; ++kt) {
      f32x4 sh[4];
#pragma unroll
      for (int h = 0; h < 4; ++h) {
        sh[h] = (f32x4){0.f, 0.f, 0.f, 0.f};
#pragma unroll
        for (int ks = 0; ks < 2; ++ks) sh[h] = MFMA16(qf[h][ks], kf[kt][ks], sh[h]);
      }
#pragma unroll
      for (int j = 0; j < 4; ++j) {
        float sc = w[j][0] * fmaxf(sh[0][j], 0.f) + w[j][1] * fmaxf(sh[1][j], 0.f) + w[j][2] * fmaxf(sh[2][j], 0.f) + w[j][3] * fmaxf(sh[3][j], 0.f);
        sc += 0.0f;
        const unsigned u = sortable(sc);
        if (MODE == 4) {
          const unsigned um = u & himask;
          const bool eq = um == pfx[j], zr = u == 0x80000000u;
          unsigned* qx = hist + (4 * g + j) * C1_HP + 512;
          if (eq) {
            const unsigned bin = u & bmask; atomicAdd(&hist[(4 * g + j) * C1_HP + (bin >> 1)], 1u << ((bin & 1u) * 16u));
            if (!zr) { const unsigned idx = atomicAdd(&qx[320], 1u); if (idx < 64u) qx[256 + idx] = ((unsigned)n << 16) | ((unsigned)(kt * 16 + lr) << 10) | (u & 1023u); }
          }
          word[j] |= (u64)((unsigned)(__ballot(um > pfx[j]) >> (16 * g)) & 0xffffu) << (16 * kt);
          zword[j] |= (u64)((unsigned)(__ballot(zr) >> (16 * g)) & 0xffffu) << (16 * kt);
        } else if (MODE == 0 || MODE == 3) {
          if (MODE == 3) base[j] += __popc((unsigned)(__ballot(u == 0x80000000u) >> (16 * g)) & 0xffffu);
          if (((u ^ pfx[j]) & himask) == 0u) { const unsigned bin = (u >> shift) & bmask; atomicAdd(&hist[(4 * g + j) * C1_HP + (bin >> 1)], 1u << ((bin & 1u) * 16u)); }
        } else {
          const bool eq = u == pfx[j];
          const unsigned fe = (unsigned)(__ballot(eq) >> (16 * g)) & 0xffffu;
          if (MODE == 1) {
            base[j] += __popc(fe);
          } else {
            const unsigned rank = base[j] + __popc(fe & ((1u << lr) - 1u));
            const bool sel = (u > pfx[j]) || (eq && rank < need[j]);
            base[j] += __popc(fe);
            const unsigned fs = (unsigned)(__ballot(sel) >> (16 * g)) & 0xffffu;
            word[j] |= (u64)fs << (16 * kt);
          }
        }
      }
    }
    if ((MODE == 1 || MODE == 3) && lr == 0) {
#pragma unroll
      for (int j = 0; j < 4; ++j) cnt[(4 * g + j) * 64 + n] = (unsigned short)base[j];
    }
    if (MODE == 2 && lr == 0) {
#pragma unroll
      for (int j = 0; j < 4; ++j) mrow[(size_t)(4 * g + j) * 64 + n] = word[j];
    }
    if (MODE == 4 && lr == 0) {
#pragma unroll
      for (int j = 0; j < 4; ++j) { u64* qx = (u64*)(hist + (4 * g + j) * C1_HP + 512); qx[n] = word[j]; qx[64 + n] = zword[j]; }
    }
#pragma unroll
    for (int kt = 0; kt < 4; ++kt)
#pragma unroll
      for (int ks = 0; ks < 2; ++ks) kf[kt][ks] = kn[kt][ks];
  }
}

DI void c1_mfma(const Params& P, int b, int qt, int qs, char* smem) {
  char* ws = P.ws;
  const bf16_t* Pb = (const bf16_t*)(ws + OFF_P);
  u64* mask = (u64*)(ws + OFF_MASK);
  const int tid = TIDX(), lane = tid & 63, wid = tid >> 6, lr = lane & 15, g = lane >> 4;
  const size_t tok0 = (size_t)b * SEQ + qt * 64 + qs * 16;
  const int ntile = qt + 1;
  if (ntile <= 4) {
    for (int i = tid; i < 16 * ntile; i += 256) mask[(tok0 + i / ntile) * 64 + (i % ntile)] = ~0ull;
    return;
  }
  constexpr int HP = C1_HP;
  unsigned* hist = (unsigned*)smem;
  unsigned short* cnt = (unsigned short*)(smem + 16 * HP * 4);
  unsigned* res = (unsigned*)(smem + 16 * HP * 4 + 2048);
  bf16x8 qf[4][2];
#pragma unroll
  for (int h = 0; h < 4; ++h)
#pragma unroll
    for (int ks = 0; ks < 2; ++ks) qf[h][ks] = *(const bf16x8*)(Pb + (tok0 + lr) * PW + C_IQ + h * 64 + ks * 32 + 8 * g);
  float w[4][4];
#pragma unroll
  for (int j = 0; j < 4; ++j) {
    const uint2 wv = *(const uint2*)(Pb + (tok0 + 4 * g + j) * PW + C_IW);
    w[j][0] = lo_f(wv.x); w[j][1] = hi_f(wv.x); w[j][2] = lo_f(wv.y); w[j][3] = hi_f(wv.y);
  }
  const bf16_t* kbase = Pb + ((size_t)b * SEQ + lr) * PW + C_IK + 8 * g;
  u64* mrow = mask + tok0 * 64;
  for (int i = tid; i < 16 * HP; i += 256) hist[i] = 0u;
  if (tid < 16) { res[tid] = 0u; res[16 + tid] = 256u; res[32 + tid] = 0u; }
  if (tid == 0) { res[48] = 0u; res[49] = 0u; res[50] = 0u; }
  bool zflag = false;
  unsigned prefix[4] = {0u, 0u, 0u, 0u}, need[4] = {256u, 256u, 256u, 256u};
  bool any_tie = false;
  __syncthreads();
#pragma unroll 1
  for (int pass = 0; pass < 3; ++pass) {
    const int shift = pass == 0 ? 21 : (pass == 1 ? 10 : 0);
    const int width = pass == 2 ? 10 : 11;
    const unsigned bmask = (1u << width) - 1u;
    const unsigned himask = pass == 0 ? 0u : (0xffffffffu << (shift + width));
    unsigned pfx[4];
#pragma unroll
    for (int j = 0; j < 4; ++j) pfx[j] = pass == 0 ? 0u : (prefix[j] << (shift + width));
    if (pass == 2) c1_pass<4>(kbase, ntile, wid, lr, g, qf, w, pfx, need, himask, shift, bmask, false, hist, cnt, mrow);
    else c1_pass<0>(kbase, ntile, wid, lr, g, qf, w, pfx, need, himask, shift, bmask, false, hist, cnt, mrow);
    __syncthreads();
    {
      const int q = 4 * wid + (lane >> 4), p = lane & 15;
      const int nw = (1 << width) >> 5;
      const unsigned* hq = hist + q * HP + p * nw;
      unsigned S = 0u;
      for (int i = 0; i < nw; i += 4) { const uint4 v = *(const uint4*)(hq + i); S += (v.x & 0xffffu) + (v.x >> 16) + (v.y & 0xffffu) + (v.y >> 16) + (v.z & 0xffffu) + (v.z >> 16) + (v.w & 0xffffu) + (v.w >> 16); }
      unsigned suf = S;
#pragma unroll
      for (int d = 1; d < 16; d <<= 1) { const unsigned t = __shfl_down(suf, d, 16); if (p + d < 16) suf += t; }
      const unsigned above = suf - S;
      const unsigned nd = res[16 + q];
      if (above < nd && nd <= above + S) {
        unsigned cum = above, fbin = 0u, fcum = 0u, fc = 0u; bool found = false;
        for (int i = nw - 1; i >= 0; --i) {
          const unsigned wv = hq[i];
          const unsigned chi = wv >> 16, clo = wv & 0xffffu;
          if (!found && cum + chi >= nd) { found = true; fbin = 2 * (p * nw + i) + 1; fcum = cum; fc = chi; }
          cum += chi;
          if (!found && cum + clo >= nd) { found = true; fbin = 2 * (p * nw + i); fcum = cum; fc = clo; }
          cum += clo;
        }
        const unsigned key = (res[q] << width) | fbin;
        res[q] = key; res[16 + q] = nd - fcum; res[32 + q] = fc;
        if (pass == 2 && nd - fcum < fc) { res[48] = 1u; if (key != 0x80000000u) res[49] = 1u; }
      }
    }
    __syncthreads();
    if (pass < 2) { for (int i = tid; i < 16 * HP; i += 256) hist[i] = 0u; }
#pragma unroll
    for (int j = 0; j < 4; ++j) { prefix[j] = res[4 * g + j]; need[j] = res[16 + 4 * g + j]; }
    any_tie = res[48] != 0u;
    if (pass == 1) {
#pragma unroll
      for (int q = 0; q < 16; ++q) zflag = zflag || (res[q] == (0x80000000u >> 10));
    }
    __syncthreads();
  }
  if (tid < 16 && hist[tid * HP + 512 + 320] > 64u) res[50] = 1u;
  __syncthreads();
  const bool fallback = res[49] != 0u || res[50] != 0u;
  if (!fallback) {
    if (tid < 16) {
      unsigned* qx = hist + tid * HP + 512;
      u64* prov = (u64*)qx; const u64* zw = (const u64*)(qx + 128);
      const unsigned key = res[tid], thr10 = key & 1023u, nc = qx[320];
      for (unsigned i = 0; i < nc; ++i) {
        const unsigned e = qx[256 + i];
        if ((e & 1023u) >= thr10) prov[e >> 16] |= 1ull << ((e >> 10) & 63u);
      }
      if (key == 0x80000000u) {
        unsigned left = res[16 + tid];
        for (int n = 0; n < ntile && left > 0u; ++n) {
          u64 z = zw[n]; const unsigned c = (unsigned)__popcll(z);
          if (c <= left) { prov[n] |= z; left -= c; }
          else { u64 take = 0ull; for (; left > 0u; --left) { const u64 t = z & (0ull - z); take |= t; z ^= t; } prov[n] |= take; }
        }
      }
    }
    __syncthreads();
    for (int i = tid; i < 16 * ntile; i += 256) { const int q = i / ntile, n = i - q * ntile; mrow[(size_t)q * 64 + n] = ((const u64*)(hist + q * HP + 512))[n]; }
    return;
  }
  if (any_tie) {
    __syncthreads();
    c1_pass<1>(kbase, ntile, wid, lr, g, qf, w, prefix, need, 0u, 0, 0u, true, hist, cnt, mrow);
    __syncthreads();
    if (tid < 16) {
      unsigned run = 0u;
      for (int n = 0; n < ntile; ++n) { const unsigned c = cnt[tid * 64 + n]; cnt[tid * 64 + n] = (unsigned short)run; run += c; }
    }
    __syncthreads();
  }
  c1_pass<2>(kbase, ntile, wid, lr, g, qf, w, prefix, need, 0u, 0, 0u, any_tie, hist, cnt, mrow);
}

DI void phase_attn1(const Params& P, int l, char* smem, bool dry, int only = 0) {
  unsigned* ctr = (unsigned*)(P.ws + OFF_CTR) + l * 4 + (dry ? 2 : 0);
  bf16_t* Pb_ = (bf16_t*)(P.ws + OFF_P); bf16_t* xb_ = (bf16_t*)(P.ws + OFF_XB);
  bf16_t* ya = dry ? xb_ : Pb_ + C_AQ; bf16_t* yb = dry ? xb_ + 512 : Pb_ + C_BQ; const size_t yp_ = dry ? 1024 : PW;
  const float lam = compute_lam(P, l);
  const int per = 16 + 16 + 32, total = 64 * per;
  for (;;) {
    const int it = next_item(ctr, smem);
    if (it >= total) break;
    const int qt = 63 - it / per, r = it % per;
    if (only && (only == 1) != (r < 16) && (only == 2) != (r >= 16 && r < 32) && (only == 3) != (r >= 32)) continue;
    if (only && !((only == 1 && r < 16) || (only == 2 && r >= 16 && r < 32) || (only == 3 && r >= 32))) continue;
    if (r < 16) c1_mfma(P, r >> 2, qt, r & 3, smem);
    else if (r < 32) attn_A(P, l, (r - 16) >> 2, (r - 16) & 3, qt, lam, smem, ya, yp_);
    else attn_B(P, (r - 32) >> 3, (r - 32) & 7, qt, smem, yb, yp_);
  }
}
DI void phase_attn2(const Params& P, int l, char* smem, bool dry) {
  unsigned* ctr = (unsigned*)(P.ws + OFF_CTR) + l * 4 + (dry ? 3 : 1);
  bf16_t* yc = dry ? (bf16_t*)(P.ws + OFF_XB) : (bf16_t*)(P.ws + OFF_P) + C_CQ; const size_t yp_ = dry ? 1024 : PW;
  const int total = 32 * 32;
  for (;;) {
    const int it = next_item(ctr, smem);
    if (it >= total) break;
    const int qp = 31 - it / 32, r = it % 32;
    attn_C2x(P, r >> 3, r & 7, qp, smem, yc, yp_);
  }
}

DI void phase_merge(const Params& P, int l, char* smem) {
  char* ws = P.ws;
  const bf16_t* Pb = (const bf16_t*)(ws + OFF_P);
  const bf16_t* W = (const bf16_t*)(ws + OFF_W) + (size_t)l * W_LAYER;
  bf16_t* MB = (bf16_t*)(ws + OFF_VT);
  const int tid = TIDX(), lane = tid & 63, wid = tid >> 6, wm = wid >> 1, wn = wid & 1, lr = lane & 15, g = lane >> 4;
  {
    const float4* src = (const float4*)(P.p + (size_t)l * NTOK * PLE); uint2* dst = (uint2*)(ws + OFF_PB);
    for (int i = BIDX() * 256 + tid; i < NTOK * PLE / 4; i += gridDim.x * 256) { const float4 v = src[i]; dst[i] = make_uint2(pack2(v.x, v.y), pack2(v.z, v.w)); }
  }
  for (int vb = BIDX(); vb < tile_groups(128, 8); vb += gridDim.x) {
    int tm, tn; if (!tile_of(vb, 128, 8, tm, tn)) continue;
    const int m0 = tm * 128, n0 = tn * 128;
    const int row0 = m0 + wm * 64, col0 = n0 + wn * 64;
    unsigned tot[4][4][2];
#pragma unroll 1
    for (int br = 0; br < 3; ++br) {
      f32x4 acc[4][4]; zero_acc(acc);
      const int ycol = br == 0 ? C_AQ : (br == 1 ? C_BQ : C_CQ);
      const bf16_t* Wb = W + (br == 0 ? WO_BRA : (br == 1 ? WO_BRB : WO_BRC));
      gemm_kloop<false, true, 8>(acc, Pb + (size_t)m0 * PW + ycol, PW, Wb + (size_t)n0 * 512, 512, smem);
#pragma unroll
      for (int mt = 0; mt < 4; ++mt) {
        const int row = row0 + mt * 16 + lr;
#pragma unroll
        for (int nt = 0; nt < 4; ++nt) {
          const uint2 gu = *(const uint2*)(Pb + (size_t)row * PW + C_GL + br * 1024 + col0 + nt * 16 + 4 * g);
          float t0 = lo_f(gu.x) * acc[mt][nt][0], t1 = hi_f(gu.x) * acc[mt][nt][1], t2 = lo_f(gu.y) * acc[mt][nt][2], t3 = hi_f(gu.y) * acc[mt][nt][3];
          if (br > 0) { t0 += lo_f(tot[mt][nt][0]); t1 += hi_f(tot[mt][nt][0]); t2 += lo_f(tot[mt][nt][1]); t3 += hi_f(tot[mt][nt][1]); }
          tot[mt][nt][0] = pack2(t0, t1); tot[mt][nt][1] = pack2(t2, t3);
        }
      }
    }
#pragma unroll
    for (int mt = 0; mt < 4; ++mt) {
      const int row = row0 + mt * 16 + lr;
#pragma unroll
      for (int nt = 0; nt < 4; ++nt)
        *(uint2*)(MB + (size_t)row * DM + col0 + nt * 16 + 4 * g) = make_uint2(tot[mt][nt][0], tot[mt][nt][1]);
    }
  }
}

DI void phase_resgemm(const Params& P, const bf16_t* A, int K, const bf16_t* Wt, float* ssq_out, char* smem) {
  bf16_t* xb = (bf16_t*)(P.ws + OFF_XB);
  const int wid = TIDX() >> 6, wm = wid >> 1, wn = wid & 1;
  for (int vb = BIDX(); vb < tile_groups(128, 8); vb += gridDim.x) {
    int tm, tn; if (!tile_of(vb, 128, 8, tm, tn)) continue;
    const int m0 = tm * 128, n0 = tn * 128;
    f32x4 acc[4][4]; zero_acc(acc);
    if (K == 1024) gemm_kloop<false, true, 16>(acc, A + (size_t)m0 * K, K, Wt + (size_t)n0 * K, K, smem);
    else gemm_kloop<false, true, 64>(acc, A + (size_t)m0 * K, K, Wt + (size_t)n0 * K, K, smem);
    epi_residual(acc, m0 + wm * 64, n0 + wn * 64, P.out, xb, ssq_out, true, true);
  }
}

template <int VAR> DI void phase_up(const Params& P, int l, char* smem) {
  char* ws = P.ws;
  const bf16_t* xb = (const bf16_t*)(ws + OFF_XB);
  const bf16_t* Wt = (const bf16_t*)(ws + OFF_W) + (size_t)l * W_LAYER + WO_UP;
  bf16_t* U = (bf16_t*)(ws + OFF_P);
  const float* ssq = (const float*)(ws + OFF_SSQ) + (size_t)1 * NTOK * 16;
  const int tid = TIDX(), lane = tid & 63, wid = tid >> 6, wm = wid >> 1, wn = wid & 1, lr = lane & 15, g = lane >> 4;
  for (int vb = BIDX(); vb < tile_groups(128, 32); vb += gridDim.x) {
    int tm, tn; if (!tile_of(vb, 128, 32, tm, tn)) continue;
    const int m0 = tm * 128, n0 = tn * 128;
    const int row0 = m0 + wm * 64, col0 = n0 + wn * 64;
    f32x4 acc[4][4]; zero_acc(acc);
    float rs[4]; load_rstd(rs, ssq, row0, lr);
    gemm_kloop<false, true, 16, VAR>(acc, xb + (size_t)m0 * DM, DM, Wt + (size_t)n0 * DM, DM, smem);
#pragma unroll
    for (int mt = 0; mt < 4; ++mt) {
      const int row = row0 + mt * 16 + lr;
#pragma unroll
      for (int nt = 0; nt < 4; ++nt) {
        float v[4];
#pragma unroll
        for (int j = 0; j < 4; ++j) { const float a = fmaxf(acc[mt][nt][j] * rs[mt], 0.f); v[j] = a * a; }
        *(uint2*)(U + (size_t)row * DFF + col0 + nt * 16 + 4 * g) = make_uint2(pack2(v[0], v[1]), pack2(v[2], v[3]));
      }
    }
  }
}

DI void phase_ple(const Params& P, int l, char* smem) {
  char* ws = P.ws;
  bf16_t* xb = (bf16_t*)(ws + OFF_XB);
  const bf16_t* W = (const bf16_t*)(ws + OFF_W) + (size_t)l * W_LAYER;
  const float* ssq = (const float*)(ws + OFF_SSQ) + (size_t)2 * NTOK * 16;
  float* ssq_out = (float*)(ws + OFF_SSQ);
  const bf16_t* pl = (const bf16_t*)(ws + OFF_PB);
  bf16_t* xb2 = (bf16_t*)(ws + OFF_XB2);
  const int tid = TIDX(), lane = tid & 63, wid = tid >> 6, wm = wid >> 1, wn = wid & 1, lr = lane & 15;
  for (int vb = BIDX(); vb < tile_groups(128, 8); vb += gridDim.x) {
    int tm, tn; if (!tile_of(vb, 128, 8, tm, tn)) continue;
    const int m0 = tm * 128, n0 = tn * 128;
    const int row0 = m0 + wm * 64, col0 = n0 + wn * 64;
    uint4* park = (uint4*)(ws + OFF_VT) + ((size_t)BIDX() * 256 + tid) * 8;
    {
      f32x4 pp[4][4]; zero_acc(pp);
      gemm_kloop<false, true, 4>(pp, pl + (size_t)m0 * PLE, PLE, W + WO_PP + (size_t)n0 * PLE, PLE, smem);
#pragma unroll
      for (int mt = 0; mt < 4; ++mt)
#pragma unroll
        for (int h = 0; h < 2; ++h)
          park[mt * 2 + h] = make_uint4(pack2(pp[mt][2 * h][0], pp[mt][2 * h][1]), pack2(pp[mt][2 * h][2], pp[mt][2 * h][3]), pack2(pp[mt][2 * h + 1][0], pp[mt][2 * h + 1][1]), pack2(pp[mt][2 * h + 1][2], pp[mt][2 * h + 1][3]));
    }
    f32x4 acc[4][4]; zero_acc(acc);
    float rs[4]; load_rstd(rs, ssq, row0, lr);
    gemm_kloop<false, true, 16>(acc, xb + (size_t)m0 * DM, DM, W + WO_GATE + (size_t)n0 * DM, DM, smem);
#pragma unroll
    for (int mt = 0; mt < 4; ++mt)
#pragma unroll
      for (int h = 0; h < 2; ++h) {
        const uint4 q = park[mt * 2 + h];
        acc[mt][2 * h][0] = sigmoidf_(acc[mt][2 * h][0] * rs[mt]) * lo_f(q.x);
        acc[mt][2 * h][1] = sigmoidf_(acc[mt][2 * h][1] * rs[mt]) * hi_f(q.x);
        acc[mt][2 * h][2] = sigmoidf_(acc[mt][2 * h][2] * rs[mt]) * lo_f(q.y);
        acc[mt][2 * h][3] = sigmoidf_(acc[mt][2 * h][3] * rs[mt]) * hi_f(q.y);
        acc[mt][2 * h + 1][0] = sigmoidf_(acc[mt][2 * h + 1][0] * rs[mt]) * lo_f(q.z);
        acc[mt][2 * h + 1][1] = sigmoidf_(acc[mt][2 * h + 1][1] * rs[mt]) * hi_f(q.z);
        acc[mt][2 * h + 1][2] = sigmoidf_(acc[mt][2 * h + 1][2] * rs[mt]) * lo_f(q.w);
        acc[mt][2 * h + 1][3] = sigmoidf_(acc[mt][2 * h + 1][3] * rs[mt]) * hi_f(q.w);
      }
    epi_residual(acc, row0, col0, P.out, xb2, ssq_out, l + 1 < DEPTH, l + 1 < DEPTH);
  }
}


#define XB_TMO      128
#define XB_XCNT(j)  (256  + 64 * (j))
#define XB_XSUB(j)  (1280 + 64 * (j))
#define XB_XGEN(j)  (2304 + 64 * (j))
#define XB_TOP      3328
#define XB_TOPGEN   3392
#define XCD_BAR_WORDS 3456
#define XB_SPIN_CAP (1u << 20)
#define LAS __attribute__((address_space(3)))
DI unsigned xb_ld(unsigned* p)              { return __hip_atomic_load(p, __ATOMIC_RELAXED, __HIP_MEMORY_SCOPE_AGENT); }
DI unsigned xb_add(unsigned* p, unsigned v) { return __hip_atomic_fetch_add(p, v, __ATOMIC_RELAXED, __HIP_MEMORY_SCOPE_AGENT); }
DI unsigned xb_xcc_id() { return (unsigned)__builtin_amdgcn_s_getreg((3 << 11) | 20) & 0xFu; }
#define XB_SPIN(cond, bar) do { unsigned _sp = 0; while (cond) { __builtin_amdgcn_s_sleep(1); \
    if ((++_sp & 255u) == 0u) { if (xb_ld(&(bar)[XB_TMO])) break; if (_sp > XB_SPIN_CAP) { atomicAdd(&(bar)[XB_TMO], 1u); break; } } } } while (0)
struct XcdBarrier { unsigned* bar; unsigned x; volatile LAS unsigned* st; };
DI XcdBarrier xcd_barrier_post(unsigned* bar, volatile LAS unsigned* st) {
  XcdBarrier b; b.bar = bar; b.x = xb_xcc_id(); b.st = st;
  if (threadIdx.x == 0) (void)xb_add(&bar[XB_XCNT(b.x)], 1u);
  return b;
}
DI void xcd_barrier_complete(unsigned* bar, unsigned x, unsigned& nloc, unsigned& nx) {
  const unsigned G = gridDim.x * gridDim.y * gridDim.z;
  unsigned sum, cnt, mine, sp = 0u;
  for (;;) {
    sum = 0u; cnt = 0u; mine = 0u;
#pragma unroll
    for (unsigned j = 0; j < 16; ++j) { const unsigned c = xb_ld(&bar[XB_XCNT(j)]); sum += c; cnt += (c > 0u) ? 1u : 0u; mine = (j == x) ? c : mine; }
    if (sum == G) break;
    __builtin_amdgcn_s_sleep(1);
    if ((++sp & 255u) == 0u) { if (xb_ld(&bar[XB_TMO])) break; if (sp > XB_SPIN_CAP) { atomicAdd(&bar[XB_TMO], 1u); break; } }
  }
  nloc = mine > 0u ? mine : 1u; nx = cnt > 0u ? cnt : 1u;
}
DI void xcd_barrier(const XcdBarrier& b) {
  asm volatile("s_waitcnt vmcnt(0)" ::: "memory");
  __syncthreads();
  if (threadIdx.x == 0) {
    unsigned* bar = b.bar;
    __builtin_amdgcn_s_waitcnt(0);
    unsigned nloc = b.st[0], nx = b.st[1];
    if (nloc == 0u) { xcd_barrier_complete(bar, b.x, nloc, nx); b.st[0] = nloc; b.st[1] = nx; }
    const unsigned old = xb_add(&bar[XB_XSUB(b.x)], 1u);
    const unsigned gen = old / nloc;
    if (old + 1u == (gen + 1u) * nloc) {
      __builtin_amdgcn_fence(__ATOMIC_RELEASE, "agent");
      asm volatile("s_waitcnt vmcnt(0)" ::: "memory");
      const unsigned og = xb_add(&bar[XB_TOP], 1u);
      const unsigned tg = og / nx;
      if (og + 1u == (tg + 1u) * nx) xb_add(&bar[XB_TOPGEN], 1u);
      else XB_SPIN(xb_ld(&bar[XB_TOPGEN]) == tg, bar);
      __builtin_amdgcn_fence(__ATOMIC_ACQUIRE, "agent");
      xb_add(&bar[XB_XGEN(b.x)], 1u);
      asm volatile("s_waitcnt vmcnt(0)" ::: "memory");
    } else {
      XB_SPIN(xb_ld(&bar[XB_XGEN(b.x)]) == gen, bar);
      __builtin_amdgcn_fence(__ATOMIC_ACQUIRE, "agent");
      asm volatile("s_waitcnt vmcnt(0)" ::: "memory");
    }
  }
  __syncthreads();
}

template <int PH> DI void run_phase(const Params& P, int l, char* smem, bool dry = false) {
  char* ws = P.ws;
  if (PH == 0) phase0(P, smem);
  if (PH == 1) phase_proj(P, l, smem);
  if (PH == 2) phase_attn1(P, l, smem, dry, dry ? (PROBE_REP >= 21 ? PROBE_REP - 20 : 0) : 0);
  if (PH == 3) phase_attn2(P, l, smem, dry);
  if (PH == 4) phase_merge(P, l, smem);
  if (PH == 5) phase_resgemm(P, (const bf16_t*)(ws + OFF_VT), 1024, (const bf16_t*)(ws + OFF_W) + (size_t)l * W_LAYER + WO_OUT, (float*)(ws + OFF_SSQ) + (size_t)1 * NTOK * 16, smem);
  if (PH == 6) { if (dry) phase_up<PROBE_VAR>(P, l, smem); else phase_up<0>(P, l, smem); }
  if (PH == 7) phase_resgemm(P, (const bf16_t*)(ws + OFF_P), 4096, (const bf16_t*)(ws + OFF_W) + (size_t)l * W_LAYER + WO_DOWN, (float*)(ws + OFF_SSQ) + (size_t)2 * NTOK * 16, smem);
  if (PH == 8) phase_ple(P, l, smem);
}

#if MULTI_LAUNCH
template <int PH> __global__ void __launch_bounds__(256, 2) phase_kernel(Params P, int l) {
  __shared__ __attribute__((aligned(16))) char smem[SMEM_TOTAL];
  run_phase<PH>(P, l, smem);
}
#else
__global__ void __launch_bounds__(256, 2) fwd_megakernel(Params P) {
  __shared__ __attribute__((aligned(16))) char smem[SMEM_TOTAL];
  __shared__ uint4 xb_words;
  cg::grid_group grid = cg::this_grid();
  if (threadIdx.x == 0) xb_words = make_uint4(0u, 0u, 0u, 0u);
  __syncthreads();
  const XcdBarrier xb = xcd_barrier_post((unsigned*)(P.ws + OFF_BAR), (volatile LAS unsigned*)&xb_words);
#define GSYNC() xcd_barrier(xb)
  run_phase<0>(P, 0, smem);
  grid.sync();
  if (PROBE_REP == 10) { run_phase<0>(P, 0, smem); GSYNC(); }
  if (PROBE_REP == 11) { for (int i = 0; i < 40; ++i) GSYNC(); }
  for (int l = 0; l < DEPTH; ++l) {
    if (PROBE_REP == 1) { run_phase<1>(P, l, smem); GSYNC(); }
    run_phase<1>(P, l, smem); GSYNC();
    if (PROBE_REP == 2 || PROBE_REP >= 21) { run_phase<2>(P, l, smem, true); GSYNC(); }
    run_phase<2>(P, l, smem); GSYNC();
    if (PROBE_REP == 3) { run_phase<3>(P, l, smem, true); GSYNC(); }
    run_phase<3>(P, l, smem); GSYNC();
    if (PROBE_REP == 4) { run_phase<4>(P, l, smem); GSYNC(); }
    run_phase<4>(P, l, smem); GSYNC();
    run_phase<5>(P, l, smem); GSYNC();
    if (PROBE_REP == 6) { run_phase<6>(P, l, smem, true); GSYNC(); }
    run_phase<6>(P, l, smem); GSYNC();
    run_phase<7>(P, l, smem); GSYNC();
    run_phase<8>(P, l, smem);
    if (l + 1 < DEPTH) GSYNC();
  }
#undef GSYNC
}
#endif

extern "C" void kernel_launch(void* const* d_in, const int* in_sizes, int n_in, void* d_out, int out_size, void* d_ws, size_t ws_size, hipStream_t stream) {
  Params P{};
  P.x = (const float*)d_in[0]; P.p = (const float*)d_in[1]; P.pos = (const int*)d_in[2];
  P.attn_norm = (const float*)d_in[3]; P.w_in = (const float*)d_in[4]; P.a_q_norm = (const float*)d_in[5]; P.a_k_norm = (const float*)d_in[6];
  P.a_lambda = (const float*)d_in[7]; P.a_subln = (const float*)d_in[8]; P.c_q_norm = (const float*)d_in[9]; P.c_k_norm = (const float*)d_in[10];
  P.idx_k_norm = (const float*)d_in[11]; P.w_br_a = (const float*)d_in[12]; P.w_br_b = (const float*)d_in[13]; P.w_br_c = (const float*)d_in[14];
  P.w_out = (const float*)d_in[15]; P.mlp_norm = (const float*)d_in[16]; P.w_up = (const float*)d_in[17]; P.w_down = (const float*)d_in[18];
  P.ple_norm = (const float*)d_in[19]; P.w_ple_gate = (const float*)d_in[20]; P.w_ple_proj = (const float*)d_in[21];
  P.out = (float*)d_out; P.ws = (char*)d_ws;
  for (int i = 0; i < 32; ++i) P.inv_freq[i] = powf(10000.0f, -(float)(2 * i) / 64.0f);
  for (int i = 0; i < 4; ++i) P.lam_init[i] = (float)(0.8 - 0.6 * exp(-0.3 * (double)i));
  if (ws_size < WS_NEED) { fprintf(stderr, "workspace too small: %zu < %zu\n", ws_size, (size_t)WS_NEED); return; }
#if MULTI_LAUNCH
  const int G = 512;
  phase_kernel<0><<<G, 256, 0, stream>>>(P, 0);
  for (int l = 0; l < DEPTH; ++l) {
    phase_kernel<1><<<G, 256, 0, stream>>>(P, l);
    phase_kernel<2><<<G, 256, 0, stream>>>(P, l);
    phase_kernel<3><<<G, 256, 0, stream>>>(P, l);
    phase_kernel<4><<<G, 256, 0, stream>>>(P, l);
    phase_kernel<5><<<G, 256, 0, stream>>>(P, l);
    phase_kernel<6><<<G, 256, 0, stream>>>(P, l);
    phase_kernel<7><<<G, 256, 0, stream>>>(P, l);
    phase_kernel<8><<<G, 256, 0, stream>>>(P, l);
  }
#else
  static int grid_blocks = 0;
  if (!grid_blocks) {
    int dev = 0, cus = 0, per_cu = 0;
    hipGetDevice(&dev);
    hipDeviceGetAttribute(&cus, hipDeviceAttributeMultiprocessorCount, dev);
    hipOccupancyMaxActiveBlocksPerMultiprocessor(&per_cu, fwd_megakernel, 256, 0);
    if (per_cu > 2) per_cu = 2;
    grid_blocks = cus * per_cu;
  }
  hipMemsetAsync((char*)d_ws + OFF_CTR, 0, 4096 + 16384, stream);
  void* args[] = {&P};
  hipError_t e = hipLaunchCooperativeKernel((void*)fwd_megakernel, dim3(grid_blocks), dim3(256), args, 0, stream);
  if (e != hipSuccess) fprintf(stderr, "cooperative launch failed: %s (grid %d)\n", hipGetErrorString(e), grid_blocks);
#endif
}
```

```cpp
#include <hip/hip_runtime.h>
#include <hip/hip_cooperative_groups.h>
#include <cstdio>
#include <cmath>
namespace cg = cooperative_groups;

#ifndef MULTI_LAUNCH
#define MULTI_LAUNCH 0
#endif
#define PROBE_REP 0

typedef unsigned short bf16_t;
typedef _Float16 bf16x8 __attribute__((ext_vector_type(8)));
typedef float f32x4 __attribute__((ext_vector_type(4)));
typedef _Float16 h2_t __attribute__((ext_vector_type(2)));
typedef float f2_t __attribute__((ext_vector_type(2)));
typedef unsigned long long u64;

#define DI __device__ __forceinline__
DI int TIDX() { int t = threadIdx.x; asm volatile("" : "+v"(t)); return t; }
DI int BIDX() { int b = blockIdx.x; asm volatile("" : "+s"(b)); return b; }

constexpr int DM = 1024, NB = 4, SEQ = 4096, NTOK = NB * SEQ, DEPTH = 4, DFF = 4096, PLE = 256;
constexpr int WIN_SRC = 8004, WIN_N = 8064, PW = 6528;
constexpr int C_AQ = 0, C_AK = 512, C_BQ = 1024, C_BK = 1536, C_CQ = 2048, C_CK = 2560, C_IQ = 3072, C_IK = 3328, C_IW = 3392, C_GL = 3456;
constexpr float EPS = 1e-6f;

constexpr size_t WO_IN = 0;
constexpr size_t WO_BRA = WO_IN + (size_t)WIN_N * 1024;
constexpr size_t WO_BRB = WO_BRA + 1024 * 512;
constexpr size_t WO_BRC = WO_BRB + 1024 * 512;
constexpr size_t WO_OUT = WO_BRC + 1024 * 512;
constexpr size_t WO_UP = WO_OUT + 1024 * 1024;
constexpr size_t WO_DOWN = WO_UP + 4096 * 1024;
constexpr size_t WO_GATE = WO_DOWN + 1024 * 4096;
constexpr size_t WO_PP = WO_GATE + 1024 * 1024;
constexpr size_t W_LAYER = WO_PP + 1024 * 256;

constexpr size_t OFF_W = 0;
constexpr size_t OFF_P = OFF_W + W_LAYER * 2 * DEPTH;
constexpr size_t OFF_VT = OFF_P + (size_t)NTOK * PW * 2;
constexpr size_t OFF_XB = OFF_VT + (size_t)3 * NB * 512 * SEQ * 2;
constexpr size_t OFF_MASK = OFF_XB + (size_t)NTOK * DM * 2;
constexpr size_t OFF_COS = OFF_MASK + (size_t)NTOK * 64 * 8;
constexpr size_t OFF_SIN = OFF_COS + (size_t)NTOK * 32 * 4;
constexpr size_t OFF_SSQ = OFF_SIN + (size_t)NTOK * 32 * 4;
constexpr size_t OFF_CTR = OFF_SSQ + (size_t)3 * NTOK * 16 * 4;
constexpr size_t OFF_BAR = OFF_CTR + 4096;
constexpr size_t OFF_PB = OFF_BAR + 16384;
constexpr size_t OFF_XB2 = OFF_PB + (size_t)NTOK * PLE * 2;
constexpr size_t WS_NEED = OFF_XB2 + (size_t)NTOK * DM * 2;
static_assert(WS_NEED <= 524550144ull, "workspace budget");

struct Params {
  const float* x; const float* p; const int* pos;
  const float* attn_norm; const float* w_in; const float* a_q_norm; const float* a_k_norm; const float* a_lambda; const float* a_subln;
  const float* c_q_norm; const float* c_k_norm; const float* idx_k_norm; const float* w_br_a; const float* w_br_b; const float* w_br_c; const float* w_out;
  const float* mlp_norm; const float* w_up; const float* w_down; const float* ple_norm; const float* w_ple_gate; const float* w_ple_proj;
  float* out; char* ws;
  float inv_freq[32]; float lam_init[4];
};

constexpr int SMEM_BYTES = 73728;
constexpr int SMEM_TOTAL = SMEM_BYTES + 64;

DI float bf2f(bf16_t v) { return (float)__builtin_bit_cast(_Float16, v); }
DI unsigned pack2(float lo, float hi) { f2_t v = {lo, hi}; h2_t b = __builtin_convertvector(v, h2_t); return __builtin_bit_cast(unsigned, b); }
DI float lo_f(unsigned u) { return (float)(__builtin_bit_cast(h2_t, u)[0]); }
DI float hi_f(unsigned u) { return (float)(__builtin_bit_cast(h2_t, u)[1]); }
DI float sigmoidf_(float x) { return 1.0f / (1.0f + __expf(-x)); }

struct R2 { uint4 a, b; };
struct R4 { uint4 a, b, c, d; };
constexpr int LROW = 144;
constexpr int LTILE = 128 * 128;
DI uint4 ldA32(const float* pa) { const float4 v0 = *(const float4*)pa, v1 = *(const float4*)(pa + 4); return make_uint4(pack2(v0.x, v0.y), pack2(v0.z, v0.w), pack2(v1.x, v1.y), pack2(v1.z, v1.w)); }
#define PROBE_VAR 0
template <bool AF32, bool SWAP, int NK, int VAR = 0>
DI void gemm_kloop(f32x4 (&acc)[4][4], const void* A_, size_t lda, const bf16_t* Bt, size_t ldb, char* smem) {
  const int tid = TIDX(), lane = tid & 63, wid = tid >> 6, wm = wid >> 1, wn = wid & 1, lr = lane & 15, g = lane >> 4;
  char* sA = smem; char* sB = smem + 2 * LTILE;
  uint4 a00 = {}, a01 = {}, a02 = {}, a03 = {}, b00 = {}, b01 = {}, b02 = {}, b03 = {}, a10 = {}, a11 = {}, a12 = {}, a13 = {}, b10 = {}, b11 = {}, b12 = {}, b13 = {};
  constexpr int nk = NK;
  const int sw0 = (g ^ ((lr >> 1) & 7)) << 4, sw1 = sw0 ^ 64;
  const int r0 = tid >> 3, kc = tid & 7, kcs = kc ^ ((r0 >> 1) & 7);
#define GL_A(i, kt_) (AF32 ? ldA32((const float*)A_ + (size_t)(r0 + 32 * (i)) * lda + (kt_) * 64 + kc * 8) : *(const uint4*)((const bf16_t*)A_ + (size_t)(r0 + 32 * (i)) * lda + (kt_) * 64 + kc * 8))
#define GL_B(i, kt_) (*(const uint4*)(Bt + (size_t)(r0 + 32 * (i)) * ldb + (kt_) * 64 + kc * 8))
#define GL_LOAD(s_, kt_) if (VAR != 1) { a##s_##0 = GL_A(0, kt_); a##s_##1 = GL_A(1, kt_); a##s_##2 = GL_A(2, kt_); a##s_##3 = GL_A(3, kt_); b##s_##0 = GL_B(0, kt_); b##s_##1 = GL_B(1, kt_); b##s_##2 = GL_B(2, kt_); b##s_##3 = GL_B(3, kt_); }
#define LDS_ST1(s_, i, buf_, v) *(uint4*)(s_ + (buf_) * LTILE + (r0 + 32 * (i)) * 128 + kcs * 16) = v;
#define LDS_STORE(s_, buf_) if (VAR != 2) { LDS_ST1(sA, 0, buf_, a##s_##0) LDS_ST1(sA, 1, buf_, a##s_##1) LDS_ST1(sA, 2, buf_, a##s_##2) LDS_ST1(sA, 3, buf_, a##s_##3) LDS_ST1(sB, 0, buf_, b##s_##0) LDS_ST1(sB, 1, buf_, b##s_##1) LDS_ST1(sB, 2, buf_, b##s_##2) LDS_ST1(sB, 3, buf_, b##s_##3) }
#define MMA_TILE(buf_)                                                                                       \
  if (VAR != 3) {                                                                                            \
    const char* pa = sA + (buf_) * LTILE + (wm * 64 + lr) * 128;                                             \
    const char* pb = sB + (buf_) * LTILE + (wn * 64 + lr) * 128;                                             \
    _Pragma("unroll") for (int ks = 0; ks < 2; ++ks) {                                                       \
      bf16x8 af[4], bfr[4];                                                                                  \
      _Pragma("unroll") for (int t = 0; t < 4; ++t) { af[t] = *(const bf16x8*)(pa + t * 16 * 128 + (ks ? sw1 : sw0)); bfr[t] = *(const bf16x8*)(pb + t * 16 * 128 + (ks ? sw1 : sw0)); } \
      _Pragma("unroll") for (int mt = 0; mt < 4; ++mt)                                                       \
        _Pragma("unroll") for (int nt = 0; nt < 4; ++nt)                                                     \
          acc[mt][nt] = SWAP ? __builtin_amdgcn_mfma_f32_16x16x32_f16(bfr[nt], af[mt], acc[mt][nt], 0, 0, 0) \
                             : __builtin_amdgcn_mfma_f32_16x16x32_f16(af[mt], bfr[nt], acc[mt][nt], 0, 0, 0); \
    }                                                                                                        \
  }
  GL_LOAD(0, 0)
  GL_LOAD(1, 1)
  LDS_STORE(0, 0)
  if (VAR != 4) __syncthreads();
#pragma unroll
  for (int kt = 0; kt < nk; kt += 2) {
    if (kt + 2 < nk) { GL_LOAD(0, kt + 2) }
    MMA_TILE(0)
    LDS_STORE(1, 1)
    if (VAR != 4) __syncthreads();
    if (kt + 3 < nk) { GL_LOAD(1, kt + 3) }
    MMA_TILE(1)
    if (kt + 2 < nk) { LDS_STORE(0, 0) }
    if (VAR != 4) __syncthreads();
  }
#undef MMA_TILE
#undef GL_A
#undef GL_B
#undef LDS_ST1
#undef GL_LOAD
#undef LDS_STORE
}

DI void zero_acc(f32x4 (&acc)[4][4]) {
#pragma unroll
  for (int a = 0; a < 4; ++a)
#pragma unroll
    for (int b = 0; b < 4; ++b) acc[a][b] = (f32x4){0.f, 0.f, 0.f, 0.f};
}

DI void load_rstd(float (&rs)[4], const float* ssq, int row0, int lr) {
#pragma unroll
  for (int mt = 0; mt < 4; ++mt) {
    const float4* q = (const float4*)(ssq + (size_t)(row0 + mt * 16 + lr) * 16);
    const float4 a = q[0], b = q[1], c = q[2], d = q[3];
    const float s = ((a.x + a.y) + (a.z + a.w)) + ((b.x + b.y) + (b.z + b.w)) + ((c.x + c.y) + (c.z + c.w)) + ((d.x + d.y) + (d.z + d.w));
    rs[mt] = rsqrtf(s * (1.0f / 1024.0f) + EPS);
  }
}

DI void epi_residual(const f32x4 (&v)[4][4], int row0, int col0, float* x, bf16_t* xb, float* ssq_out, bool write_xb, bool write_ssq) {
  const int lane = TIDX() & 63, lr = lane & 15, g = lane >> 4;
#pragma unroll
  for (int mt = 0; mt < 4; ++mt) {
    const int row = row0 + mt * 16 + lr;
    float ss = 0.f;
#pragma unroll
    for (int nt = 0; nt < 4; ++nt) {
      const int col = col0 + nt * 16 + 4 * g;
      float4* px = (float4*)(x + (size_t)row * DM + col);
      float4 o = *px;
      o.x += v[mt][nt][0]; o.y += v[mt][nt][1]; o.z += v[mt][nt][2]; o.w += v[mt][nt][3];
      *px = o;
      ss += (o.x * o.x + o.y * o.y) + (o.z * o.z + o.w * o.w);
      if (write_xb) *(uint2*)(xb + (size_t)row * DM + col) = make_uint2(pack2(o.x, o.y), pack2(o.z, o.w));
    }
    if (write_ssq) {
      ss += __shfl_xor(ss, 16); ss += __shfl_xor(ss, 32);
      if (g == 0) ssq_out[(size_t)row * 16 + (col0 >> 6)] = ss;
    }
  }
}


DI bool tile_of(int vb, int MT, int NT, int& m, int& n) {
  const int ngrp_n = (NT + 7) >> 3;
  const int grp = vb >> 9, b = vb & 511;
  const int mh = grp / ngrp_n, ng = grp - mh * ngrp_n;
  const int xcd = b & 7, j = b >> 3;
  m = mh * 64 + xcd * 8 + (j & 7);
  n = ng * 8 + (j >> 3);
  return m < MT && n < NT;
}
DI int tile_groups(int MT, int NT) { return (MT >> 6) * ((NT + 7) >> 3) * 512; }

DI int map_in(int n) {
  if (n < 1024) return n;
  if (n < 2048) return n + 512;
  if (n < 3072) return n + 1024;
  if (n < 3396) return n + 1536;
  if (n < 3456) return -1;
  if (n < 6528) return n - 3456 + 4932;
  if (n < 7040) return n - 6528 + 1024;
  if (n < 7552) return n - 7040 + 2560;
  return n - 7552 + 4096;
}

DI void convert_w(const float* src, bf16_t* dst, int K, int Nsrc, int Ndst, const float* gain, bool mapin, char* smem, int& tile_base) {
  float* t = (float*)smem;
  const int tid = TIDX();
  const int tk = K >> 6, tn = Ndst >> 6, ntile = tk * tn;
  int first = (int)BIDX() - (tile_base % (int)gridDim.x); if (first < 0) first += gridDim.x;
  const int tx = tid & 15, ty = tid >> 4;
  for (int tt = first; tt < ntile; tt += 4 * gridDim.x) {
    float4 v[4][4];
#pragma unroll
    for (int u = 0; u < 4; ++u) {
      const int tu = tt + u * (int)gridDim.x;
      if (tu < ntile) {
        const int k0 = (tu % tk) * 64, n0 = (tu / tk) * 64;
        const int n = n0 + 4 * tx; const int ns = mapin ? map_in(n) : n;
#pragma unroll
        for (int i = 0; i < 4; ++i) {
          const int kk = ty + 16 * i;
          v[u][i] = make_float4(0.f, 0.f, 0.f, 0.f);
          if (ns >= 0) { v[u][i] = *(const float4*)(src + (size_t)(k0 + kk) * Nsrc + ns); if (gain) { const float gk = gain[k0 + kk]; v[u][i].x *= gk; v[u][i].y *= gk; v[u][i].z *= gk; v[u][i].w *= gk; } }
        }
      }
    }
    __syncthreads();
#pragma unroll
    for (int u = 0; u < 4; ++u) {
      if (tt + u * (int)gridDim.x < ntile) {
        float* tb = t + u * (64 * 65);
#pragma unroll
        for (int i = 0; i < 4; ++i) { const int kk = ty + 16 * i; tb[kk * 65 + 4 * tx] = v[u][i].x; tb[kk * 65 + 4 * tx + 1] = v[u][i].y; tb[kk * 65 + 4 * tx + 2] = v[u][i].z; tb[kk * 65 + 4 * tx + 3] = v[u][i].w; }
      }
    }
    __syncthreads();
#pragma unroll
    for (int u = 0; u < 4; ++u) {
      const int tu = tt + u * (int)gridDim.x;
      if (tu < ntile) {
        const int k0 = (tu % tk) * 64, n0 = (tu / tk) * 64;
        const float* tb = t + u * (64 * 65);
        const int n = tid >> 2, kq = tid & 3;
        unsigned w[8];
#pragma unroll
        for (int e = 0; e < 8; ++e) w[e] = pack2(tb[(kq * 16 + 2 * e) * 65 + n], tb[(kq * 16 + 2 * e + 1) * 65 + n]);
        uint4* d = (uint4*)(dst + (size_t)(n0 + n) * K + k0 + kq * 16);
        d[0] = make_uint4(w[0], w[1], w[2], w[3]); d[1] = make_uint4(w[4], w[5], w[6], w[7]);
      }
    }
  }
  tile_base += ntile;
}

DI void phase0(const Params& P, char* smem) {
  char* ws = P.ws;
  int tb = 0;
  for (int l = 0; l < DEPTH; ++l) {
    bf16_t* W = (bf16_t*)(ws + OFF_W) + (size_t)l * W_LAYER;
    convert_w(P.w_in + (size_t)l * 1024 * WIN_SRC, W + WO_IN, 1024, WIN_SRC, WIN_N, P.attn_norm + l * 1024, true, smem, tb);
    convert_w(P.w_br_a + (size_t)l * 512 * 1024, W + WO_BRA, 512, 1024, 1024, nullptr, false, smem, tb);
    convert_w(P.w_br_b + (size_t)l * 512 * 1024, W + WO_BRB, 512, 1024, 1024, nullptr, false, smem, tb);
    convert_w(P.w_br_c + (size_t)l * 512 * 1024, W + WO_BRC, 512, 1024, 1024, nullptr, false, smem, tb);
    convert_w(P.w_out + (size_t)l * 1024 * 1024, W + WO_OUT, 1024, 1024, 1024, nullptr, false, smem, tb);
    convert_w(P.w_up + (size_t)l * 1024 * 4096, W + WO_UP, 1024, 4096, 4096, P.mlp_norm + l * 1024, false, smem, tb);
    convert_w(P.w_down + (size_t)l * 4096 * 1024, W + WO_DOWN, 4096, 1024, 1024, nullptr, false, smem, tb);
    convert_w(P.w_ple_gate + (size_t)l * 1024 * 1024, W + WO_GATE, 1024, 1024, 1024, P.ple_norm + l * 1024, false, smem, tb);
    convert_w(P.w_ple_proj + (size_t)l * 256 * 1024, W + WO_PP, 256, 1024, 1024, nullptr, false, smem, tb);
  }
  const int gtid = BIDX() * 256 + TIDX(), gsz = gridDim.x * 256;
  float* cs = (float*)(ws + OFF_COS); float* sn = (float*)(ws + OFF_SIN);
  for (int i = gtid; i < NTOK * 32; i += gsz) {
    const int tok = i >> 5, f = i & 31;
    const float angf = (float)P.pos[tok] * P.inv_freq[f];
    const double a = (double)angf;
    const double k = rint(a * 0.15915494309189535);
    const float r = (float)(a - k * 6.283185307179586);
    cs[i] = __cosf(r); sn[i] = __sinf(r);
  }
  float* ssq = (float*)(ws + OFF_SSQ);
  bf16_t* xb = (bf16_t*)(ws + OFF_XB2);
  const int lane = TIDX() & 63, gw = gtid >> 6, nw = gsz >> 6;
  for (int row = gw; row < NTOK; row += nw) {
    const float4* src = (const float4*)(P.x + (size_t)row * DM);
    float ss = 0.f;
#pragma unroll
    for (int i = 0; i < 4; ++i) {
      const float4 v = src[lane + 64 * i];
      ss += (v.x * v.x + v.y * v.y) + (v.z * v.z + v.w * v.w);
      ((float4*)(P.out + (size_t)row * DM))[lane + 64 * i] = v;
      ((uint2*)(xb + (size_t)row * DM))[lane + 64 * i] = make_uint2(pack2(v.x, v.y), pack2(v.z, v.w));
    }
#pragma unroll
    for (int o = 32; o > 0; o >>= 1) ss += __shfl_xor(ss, o);
    if (lane < 16) ssq[(size_t)row * 16 + lane] = lane == 0 ? ss : 0.f;
  }
}

DI void phase_proj(const Params& P, int l, char* smem) {
  char* ws = P.ws;
  const bf16_t* xb = (const bf16_t*)(ws + OFF_XB2);
  const bf16_t* Wt = (const bf16_t*)(ws + OFF_W) + (size_t)l * W_LAYER + WO_IN;
  bf16_t* Pb = (bf16_t*)(ws + OFF_P);
  bf16_t* VT = (bf16_t*)(ws + OFF_VT);
  const float* ssq = (const float*)(ws + OFF_SSQ);
  const float* cs = (const float*)(ws + OFF_COS); const float* sn = (const float*)(ws + OFF_SIN);
  const int tid = TIDX(), lane = tid & 63, wid = tid >> 6, wm = wid >> 1, wn = wid & 1, lr = lane & 15, g = lane >> 4;
  for (int vb = BIDX(); vb < tile_groups(128, 63); vb += gridDim.x) {
    int tm, tn; if (!tile_of(vb, 128, 63, tm, tn)) continue;
    const int m0 = tm * 128, n0 = tn * 128;
    f32x4 acc[4][4]; zero_acc(acc);
    const int row0 = m0 + wm * 64, col0 = n0 + wn * 64;
    float rs[4]; load_rstd(rs, ssq, row0, lr);
    if (n0 >= PW) {
      gemm_kloop<false, false, 16>(acc, xb + (size_t)m0 * DM, DM, Wt + (size_t)n0 * DM, DM, smem);
      const int cb = col0 - PW;
      const int br = cb >> 9, c0 = cb & 511;
      const int b = row0 >> 12, s0 = row0 & 4095;
#pragma unroll
      for (int mt = 0; mt < 4; ++mt) {
        float r4[4];
#pragma unroll
        for (int j = 0; j < 4; ++j) r4[j] = __shfl(rs[mt], 4 * g + j);
#pragma unroll
        for (int nt = 0; nt < 4; ++nt) {
          const int c = c0 + nt * 16 + lr;
          bf16_t* dst = VT + ((size_t)(br * NB + b) * 512 + c) * SEQ + s0 + mt * 16 + 4 * g;
          *(uint2*)dst = make_uint2(pack2(acc[mt][nt][0] * r4[0], acc[mt][nt][1] * r4[1]), pack2(acc[mt][nt][2] * r4[2], acc[mt][nt][3] * r4[3]));
        }
      }
    } else {
      gemm_kloop<false, true, 16>(acc, xb + (size_t)m0 * DM, DM, Wt + (size_t)n0 * DM, DM, smem);
#pragma unroll
      for (int mt = 0; mt < 4; ++mt)
#pragma unroll
        for (int nt = 0; nt < 4; ++nt) acc[mt][nt] *= rs[mt];
      const float* gain = nullptr; bool rope = false; float sc = 1.f; bool sig = false;
      constexpr float QS = 0.125f * 1.4426950408889634f;
      if (col0 < C_AK) { gain = P.a_q_norm + l * 64; rope = true; sc = QS; }
      else if (col0 < C_BQ) { gain = P.a_k_norm + l * 64; rope = true; }
      else if (col0 < C_BK) { sc = QS; }
      else if (col0 < C_CQ) { }
      else if (col0 < C_CK) { gain = P.c_q_norm + l * 64; rope = true; sc = QS; }
      else if (col0 < C_IQ) { gain = P.c_k_norm + l * 64; rope = true; }
      else if (col0 < C_IK) { rope = true; sc = 0.125f; }
      else if (col0 < C_IW) { gain = P.idx_k_norm + l * 64; rope = true; }
      else if (col0 < C_GL) { sc = 0.5f; }
      else { sig = true; }
      if (gain) {
        float gv[4][4];
#pragma unroll
        for (int nt = 0; nt < 4; ++nt) { const float4 q = *(const float4*)(gain + nt * 16 + 4 * g); gv[nt][0] = q.x; gv[nt][1] = q.y; gv[nt][2] = q.z; gv[nt][3] = q.w; }
#pragma unroll
        for (int mt = 0; mt < 4; ++mt) {
          float ss = 0.f;
#pragma unroll
          for (int nt = 0; nt < 4; ++nt)
#pragma unroll
            for (int j = 0; j < 4; ++j) ss += acc[mt][nt][j] * acc[mt][nt][j];
          ss += __shfl_xor(ss, 16); ss += __shfl_xor(ss, 32);
          const float r = rsqrtf(ss * (1.0f / 64.0f) + EPS);
#pragma unroll
          for (int nt = 0; nt < 4; ++nt)
#pragma unroll
            for (int j = 0; j < 4; ++j) acc[mt][nt][j] *= r * gv[nt][j];
        }
      }
      if (rope) {
#pragma unroll
        for (int mt = 0; mt < 4; ++mt) {
          const int row = row0 + mt * 16 + lr;
#pragma unroll
          for (int h = 0; h < 2; ++h) {
            const float4 c4 = *(const float4*)(cs + (size_t)row * 32 + h * 16 + 4 * g);
            const float4 s4 = *(const float4*)(sn + (size_t)row * 32 + h * 16 + 4 * g);
            const float cc[4] = {c4.x, c4.y, c4.z, c4.w}, ssn[4] = {s4.x, s4.y, s4.z, s4.w};
#pragma unroll
            for (int j = 0; j < 4; ++j) {
              const float x1 = acc[mt][h][j], x2 = acc[mt][h + 2][j];
              acc[mt][h][j] = x1 * cc[j] - x2 * ssn[j];
              acc[mt][h + 2][j] = x2 * cc[j] + x1 * ssn[j];
            }
          }
        }
      }
#pragma unroll
      for (int mt = 0; mt < 4; ++mt) {
        const int row = row0 + mt * 16 + lr;
#pragma unroll
        for (int nt = 0; nt < 4; ++nt) {
          f32x4 v = acc[mt][nt] * sc;
          if (sig) { v[0] = sigmoidf_(v[0]); v[1] = sigmoidf_(v[1]); v[2] = sigmoidf_(v[2]); v[3] = sigmoidf_(v[3]); }
          *(uint2*)(Pb + (size_t)row * PW + col0 + nt * 16 + 4 * g) = make_uint2(pack2(v[0], v[1]), pack2(v[2], v[3]));
        }
      }
    }
  }
}

DI int next_item(unsigned* ctr, char* smem) {
  int* s = (int*)(smem + SMEM_BYTES);
  __syncthreads();
  if (TIDX() == 0) *s = (int)atomicAdd(ctr, 1u);
  __syncthreads();
  const int v = *s;
  return v;
}

DI float compute_lam(const Params& P, int l) {
  const int lane = TIDX() & 63;
  const float* lp = P.a_lambda + l * 256;
  float a = lp[lane] * lp[64 + lane], b = lp[128 + lane] * lp[192 + lane];
#pragma unroll
  for (int o = 32; o > 0; o >>= 1) { a += __shfl_xor(a, o); b += __shfl_xor(b, o); }
  return __expf(a) - __expf(b) + P.lam_init[l];
}

#define MFMA16(a, b, c) __builtin_amdgcn_mfma_f32_16x16x32_f16((a), (b), (c), 0, 0, 0)
DI bf16x8 pack8(const f32x4& a, const f32x4& b) {
  const uint4 u = make_uint4(pack2(a[0], a[1]), pack2(a[2], a[3]), pack2(b[0], b[1]), pack2(b[2], b[3]));
  return __builtin_bit_cast(bf16x8, u);
}
DI bf16x8 vfrag(const char* sV, int dt, int kk, int lr, int g) {
  return *(const bf16x8*)(sV + (dt * 16 + lr) * 128 + (((kk * 4 + g) ^ ((lr >> 1) & 7)) << 4));
}
DI uint4 ld_chunk(const bf16_t* gsrc, size_t gp, int c) { return *(const uint4*)(gsrc + (size_t)(c >> 3) * gp + (c & 7) * 8); }
DI void st_chunk_k(char* sdst, int c, const uint4& v) { const int row = c >> 3; *(uint4*)(sdst + row * 128 + (((c & 7) ^ ((row >> 1) & 7)) << 4)) = v; }
DI void st_chunk_v(char* sdst, int c, const uint4& v) {
  const int row = c >> 3, c8 = c & 7, kk = c8 >> 2, cc = c8 & 3, sw = (row >> 1) & 7;
  const int gq = (cc & 1) * 2, part = cc >> 1;
  char* base = sdst + row * 128 + part * 8;
  *(uint2*)(base + (((kk * 4 + gq) ^ sw) << 4)) = make_uint2(v.x, v.y);
  *(uint2*)(base + (((kk * 4 + gq + 1) ^ sw) << 4)) = make_uint2(v.z, v.w);
}
DI void gload2(R2& r, const bf16_t* gsrc, size_t gp, int tid) { r.a = ld_chunk(gsrc, gp, tid); r.b = ld_chunk(gsrc, gp, tid + 256); }
DI void gload4(R4& r, const bf16_t* gsrc, size_t gp, int tid) { r.a = ld_chunk(gsrc, gp, tid); r.b = ld_chunk(gsrc, gp, tid + 256); r.c = ld_chunk(gsrc, gp, tid + 512); r.d = ld_chunk(gsrc, gp, tid + 768); }
DI void sstoreK2(const R2& r, char* sdst, int tid) { st_chunk_k(sdst, tid, r.a); st_chunk_k(sdst, tid + 256, r.b); }
DI void sstoreV2(const R2& r, char* sdst, int tid) { st_chunk_v(sdst, tid, r.a); st_chunk_v(sdst, tid + 256, r.b); }
DI void sstoreV4(const R4& r, char* sdst, int tid) { st_chunk_v(sdst, tid, r.a); st_chunk_v(sdst, tid + 256, r.b); st_chunk_v(sdst, tid + 512, r.c); st_chunk_v(sdst, tid + 768, r.d); }
DI void qk_tile(f32x4 (&st)[4], const char* sK, const bf16x8 (&qf)[2], int lr, int g) {
#pragma unroll
  for (int kt = 0; kt < 4; ++kt) {
    st[kt] = (f32x4){0.f, 0.f, 0.f, 0.f};
#pragma unroll
    for (int ks = 0; ks < 2; ++ks) st[kt] = MFMA16(*(const bf16x8*)(sK + (kt * 16 + lr) * 128 + (((ks * 4 + g) ^ ((lr >> 1) & 7)) << 4)), qf[ks], st[kt]);
  }
}
DI void qk_tile2(f32x4 (&sa)[4], f32x4 (&sb)[4], const char* sK, const bf16x8 (&qa)[2], const bf16x8 (&qb)[2], int lr, int g) {
#pragma unroll
  for (int kt = 0; kt < 4; ++kt) {
    const bf16x8 k0 = *(const bf16x8*)(sK + (kt * 16 + lr) * 128 + ((g ^ ((lr >> 1) & 7)) << 4)), k1 = *(const bf16x8*)(sK + (kt * 16 + lr) * 128 + (((4 + g) ^ ((lr >> 1) & 7)) << 4));
    sa[kt] = MFMA16(k0, qa[0], ((f32x4){0.f, 0.f, 0.f, 0.f})); sb[kt] = MFMA16(k0, qb[0], ((f32x4){0.f, 0.f, 0.f, 0.f}));
    sa[kt] = MFMA16(k1, qa[1], sa[kt]); sb[kt] = MFMA16(k1, qb[1], sb[kt]);
  }
}
DI float softmax_step(f32x4 (&st)[4], float& m, float& lsum) {
  float mx = fmaxf(fmaxf(fmaxf(st[0][0], st[0][1]), fmaxf(st[0][2], st[0][3])), fmaxf(fmaxf(st[1][0], st[1][1]), fmaxf(st[1][2], st[1][3])));
  mx = fmaxf(mx, fmaxf(fmaxf(fmaxf(st[2][0], st[2][1]), fmaxf(st[2][2], st[2][3])), fmaxf(fmaxf(st[3][0], st[3][1]), fmaxf(st[3][2], st[3][3]))));
  mx = fmaxf(mx, __shfl_xor(mx, 16)); mx = fmaxf(mx, __shfl_xor(mx, 32));
  const float mn = fmaxf(m, mx);
  const float mu = mn == -INFINITY ? 0.f : mn;
  const float alpha = __builtin_amdgcn_exp2f(m - mu);
  float ps = 0.f;
#pragma unroll
  for (int kt = 0; kt < 4; ++kt)
#pragma unroll
    for (int j = 0; j < 4; ++j) { const float p = __builtin_amdgcn_exp2f(st[kt][j] - mu); st[kt][j] = p; ps += p; }
  lsum = lsum * alpha + ps; m = mn;
  return alpha;
}

DI void attn_A(const Params& P, int l, int b, int head, int qt, float lam, char* smem, bf16_t* ybase, size_t ypitch) {
  char* ws = P.ws;
  bf16_t* Pb = (bf16_t*)(ws + OFF_P);
  const bf16_t* VT = (const bf16_t*)(ws + OFF_VT);
  const int tid = TIDX(), lane = tid & 63, wid = tid >> 6, lr = lane & 15, g = lane >> 4;
  const size_t tokq = (size_t)b * SEQ + qt * 64 + wid * 16 + lr;
  bf16x8 qf0[2], qf1[2];
#pragma unroll
  for (int ks = 0; ks < 2; ++ks) {
    qf0[ks] = *(const bf16x8*)(Pb + tokq * PW + C_AQ + head * 128 + ks * 32 + 8 * g);
    qf1[ks] = *(const bf16x8*)(Pb + tokq * PW + C_AQ + head * 128 + 64 + ks * 32 + 8 * g);
  }
  f32x4 o0[8], o1[8];
#pragma unroll
  for (int i = 0; i < 8; ++i) { o0[i] = (f32x4){0.f, 0.f, 0.f, 0.f}; o1[i] = (f32x4){0.f, 0.f, 0.f, 0.f}; }
  float m0 = -INFINITY, m1 = -INFINITY, l0 = 0.f, l1 = 0.f;
  const bf16_t* kbase = Pb + (size_t)b * SEQ * PW + C_AK + head * 128;
  const bf16_t* vbase = VT + ((size_t)(0 * NB + b) * 512 + head * 128) * SEQ;
  constexpr int STAGE = 2 * 9216 + 18432;
  R2 rk0, rk1; R4 rv;
  gload2(rk0, kbase, PW, tid); gload2(rk1, kbase + 64, PW, tid); gload4(rv, vbase, SEQ, tid);
  sstoreK2(rk0, smem, tid); sstoreK2(rk1, smem + 9216, tid); sstoreV4(rv, smem + 18432, tid);
  __syncthreads();
  for (int n = 0; n <= qt; ++n) {
    const char* sb = smem + (n & 1) * STAGE;
    if (n < qt) {
      const bf16_t* kn = kbase + (size_t)(n + 1) * 64 * PW;
      gload2(rk0, kn, PW, tid); gload2(rk1, kn + 64, PW, tid); gload4(rv, vbase + (n + 1) * 64, SEQ, tid);
    }
    f32x4 s0[4], s1[4];
    qk_tile(s0, sb, qf0, lr, g);
    qk_tile(s1, sb + 9216, qf1, lr, g);
    const float a0 = softmax_step(s0, m0, l0), a1 = softmax_step(s1, m1, l1);
#pragma unroll
    for (int i = 0; i < 8; ++i) { o0[i] *= a0; o1[i] *= a1; }
#pragma unroll
    for (int kk = 0; kk < 2; ++kk) {
      const bf16x8 p0 = pack8(s0[2 * kk], s0[2 * kk + 1]), p1 = pack8(s1[2 * kk], s1[2 * kk + 1]);
#pragma unroll
      for (int dt = 0; dt < 8; ++dt) {
        const bf16x8 vf = vfrag(sb + 18432, dt, kk, lr, g);
        o0[dt] = MFMA16(vf, p0, o0[dt]);
        o1[dt] = MFMA16(vf, p1, o1[dt]);
      }
    }
    if (n < qt) {
      char* sn = smem + ((n + 1) & 1) * STAGE;
      sstoreK2(rk0, sn, tid); sstoreK2(rk1, sn + 9216, tid); sstoreV4(rv, sn + 18432, tid);
    }
    __syncthreads();
  }
  l0 += __shfl_xor(l0, 16); l0 += __shfl_xor(l0, 32);
  l1 += __shfl_xor(l1, 16); l1 += __shfl_xor(l1, 32);
  const float i0 = 1.0f / l0, i1 = lam / l1;
  float ss = 0.f;
#pragma unroll
  for (int dt = 0; dt < 8; ++dt)
#pragma unroll
    for (int j = 0; j < 4; ++j) { const float v = o0[dt][j] * i0 - o1[dt][j] * i1; o0[dt][j] = v; ss += v * v; }
  ss += __shfl_xor(ss, 16); ss += __shfl_xor(ss, 32);
  const float r = rsqrtf(ss * (1.0f / 128.0f) + EPS) * (1.0f - P.lam_init[l]);
  const float* sg = P.a_subln + l * 128;
  bf16_t* yp = ybase + tokq * ypitch + head * 128;
#pragma unroll
  for (int dt = 0; dt < 8; ++dt) {
    const float4 gq = *(const float4*)(sg + dt * 16 + 4 * g);
    *(uint2*)(yp + dt * 16 + 4 * g) = make_uint2(pack2(o0[dt][0] * r * gq.x, o0[dt][1] * r * gq.y), pack2(o0[dt][2] * r * gq.z, o0[dt][3] * r * gq.w));
  }
}

DI void attn_B(const Params& P, int b, int head, int qt, char* smem, bf16_t* ybase, size_t ypitch) {
  char* ws = P.ws;
  bf16_t* Pb = (bf16_t*)(ws + OFF_P);
  const bf16_t* VT = (const bf16_t*)(ws + OFF_VT);
  const int tid = TIDX(), lane = tid & 63, wid = tid >> 6, lr = lane & 15, g = lane >> 4;
  const size_t tokq = (size_t)b * SEQ + qt * 64 + wid * 16 + lr;
  bf16x8 qf[2];
#pragma unroll
  for (int ks = 0; ks < 2; ++ks) qf[ks] = *(const bf16x8*)(Pb + tokq * PW + C_BQ + head * 64 + ks * 32 + 8 * g);
  f32x4 o[4];
#pragma unroll
  for (int i = 0; i < 4; ++i) o[i] = (f32x4){0.f, 0.f, 0.f, 0.f};
  float R = 1.0f;
  const bf16_t* kbase = Pb + (size_t)b * SEQ * PW + C_BK + head * 64;
  const bf16_t* vbase = VT + ((size_t)(1 * NB + b) * 512 + head * 64) * SEQ;
  constexpr int STAGE = 2 * 9216;
  R2 rk, rv;
  gload2(rk, kbase + (size_t)qt * 64 * PW, PW, tid); gload2(rv, vbase + qt * 64, SEQ, tid);
  sstoreK2(rk, smem, tid); sstoreV2(rv, smem + 9216, tid);
  __syncthreads();
  const int ql = wid * 16 + lr;
  for (int n = qt; n >= 0; --n) {
    const int it = qt - n;
    const char* sb = smem + (it & 1) * STAGE;
    if (n > 0) { gload2(rk, kbase + (size_t)(n - 1) * 64 * PW, PW, tid); gload2(rv, vbase + (n - 1) * 64, SEQ, tid); }
    f32x4 st[4];
    qk_tile(st, sb, qf, lr, g);
    float T[4];
#pragma unroll
    for (int kt = 0; kt < 4; ++kt) {
      float be[4], om[4];
#pragma unroll
      for (int j = 0; j < 4; ++j) {
        const float z = fmaxf(st[kt][j], -43.28f);
        const float e = __builtin_amdgcn_exp2f(-z), rr = 1.0f / (1.0f + e);
        const bool ok = (n < qt) || (kt * 16 + 4 * g + j < ql);
        be[j] = ok ? rr : 0.f; om[j] = ok ? e * rr : 1.0f;
      }
      const float c2 = om[3], c1 = c2 * om[2], c0 = c1 * om[1], tot = c0 * om[0];
      const float t1 = __shfl_xor(tot, 16), t2 = __shfl_xor(tot, 32), t3 = __shfl_xor(t1, 32);
      const float G = g == 0 ? t1 * t2 * t3 : (g == 1 ? t2 * t3 : (g == 2 ? t1 : 1.0f));
      T[kt] = (tot * t1) * (t2 * t3);
      st[kt][0] = be[0] * c0 * G; st[kt][1] = be[1] * c1 * G; st[kt][2] = be[2] * c2 * G; st[kt][3] = be[3] * G;
    }
    const float H2 = T[3] * R, H1 = T[2] * H2, H0 = T[1] * H1;
    st[0] *= H0; st[1] *= H1; st[2] *= H2; st[3] *= R;
    R = T[0] * H0;
#pragma unroll
    for (int kk = 0; kk < 2; ++kk) {
      const bf16x8 pk = pack8(st[2 * kk], st[2 * kk + 1]);
#pragma unroll
      for (int dt = 0; dt < 4; ++dt) o[dt] = MFMA16(vfrag(sb + 9216, dt, kk, lr, g), pk, o[dt]);
    }
    if (n > 0) { char* sn = smem + ((it + 1) & 1) * STAGE; sstoreK2(rk, sn, tid); sstoreV2(rv, sn + 9216, tid); }
    if (!__syncthreads_or(R != 0.f)) break;
  }
  bf16_t* yp = ybase + tokq * ypitch + head * 64;
#pragma unroll
  for (int dt = 0; dt < 4; ++dt) *(uint2*)(yp + dt * 16 + 4 * g) = make_uint2(pack2(o[dt][0], o[dt][1]), pack2(o[dt][2], o[dt][3]));
}

DI unsigned sortable(float f) { const unsigned u = __float_as_uint(f); return (u & 0x80000000u) ? ~u : (u | 0x80000000u); }

DI void attn_C2x(const Params& P, int b, int head, int qp, char* smem, bf16_t* ybase, size_t ypitch) {
  char* ws = P.ws;
  bf16_t* Pb = (bf16_t*)(ws + OFF_P);
  const bf16_t* VT = (const bf16_t*)(ws + OFF_VT);
  const uint2* mask = (const uint2*)(ws + OFF_MASK);
  const int tid = TIDX(), lane = tid & 63, wid = tid >> 6, lr = lane & 15, g = lane >> 4;
  const int myc = 2 * qp + (wid >> 1);
  const size_t tok0 = (size_t)b * SEQ + qp * 128 + wid * 32 + lr;
  bf16x8 qfa[2], qfb[2];
#pragma unroll
  for (int ks = 0; ks < 2; ++ks) {
    qfa[ks] = *(const bf16x8*)(Pb + tok0 * PW + C_CQ + head * 64 + ks * 32 + 8 * g);
    qfb[ks] = *(const bf16x8*)(Pb + (tok0 + 16) * PW + C_CQ + head * 64 + ks * 32 + 8 * g);
  }
  f32x4 oa[4], ob[4];
#pragma unroll
  for (int i = 0; i < 4; ++i) { oa[i] = (f32x4){0.f, 0.f, 0.f, 0.f}; ob[i] = (f32x4){0.f, 0.f, 0.f, 0.f}; }
  float ma = -INFINITY, mb = -INFINITY, la = 0.f, lb = 0.f;
  const bf16_t* kbase = Pb + (size_t)b * SEQ * PW + C_CK + head * 64;
  const bf16_t* vbase = VT + ((size_t)(2 * NB + b) * 512 + head * 64) * SEQ;
  constexpr int STAGE = 2 * 9216;
  const int nlast = 2 * qp + 1;
#define C2X_COMPUTE(n_, sb_)                                                                                         \
  if ((n_) <= myc) {                                                                                                 \
    const uint2 mwa = mask[tok0 * 64 + (n_)], mwb = mask[(tok0 + 16) * 64 + (n_)];                                   \
    f32x4 sa[4], sbb[4];                                                                                             \
    qk_tile2(sa, sbb, (sb_), qfa, qfb, lr, g);                                                                       \
    _Pragma("unroll") for (int kt = 0; kt < 4; ++kt) {                                                               \
      const unsigned ba = ((kt < 2 ? mwa.x : mwa.y) >> ((kt & 1) * 16 + 4 * g)) & 0xFu;                              \
      const unsigned bb = ((kt < 2 ? mwb.x : mwb.y) >> ((kt & 1) * 16 + 4 * g)) & 0xFu;                              \
      _Pragma("unroll") for (int j = 0; j < 4; ++j) {                                                                \
        sa[kt][j] = ((ba >> j) & 1u) ? sa[kt][j] : -INFINITY;                                                        \
        sbb[kt][j] = ((bb >> j) & 1u) ? sbb[kt][j] : -INFINITY;                                                      \
      }                                                                                                              \
    }                                                                                                                \
    const float ala = softmax_step(sa, ma, la), alb = softmax_step(sbb, mb, lb);                                     \
    _Pragma("unroll") for (int i = 0; i < 4; ++i) { oa[i] *= ala; ob[i] *= alb; }                                    \
    _Pragma("unroll") for (int kk = 0; kk < 2; ++kk) {                                                               \
      const bf16x8 pa = pack8(sa[2 * kk], sa[2 * kk + 1]), pb = pack8(sbb[2 * kk], sbb[2 * kk + 1]);                 \
      _Pragma("unroll") for (int dt = 0; dt < 4; ++dt) {                                                             \
        const bf16x8 vf = vfrag((sb_) + 9216, dt, kk, lr, g);                                                        \
        oa[dt] = MFMA16(vf, pa, oa[dt]);                                                                             \
        ob[dt] = MFMA16(vf, pb, ob[dt]);                                                                             \
      }                                                                                                              \
    }                                                                                                                \
  }
  R2 rk0, rv0, rk1, rv1;
  gload2(rk0, kbase, PW, tid); gload2(rv0, vbase, SEQ, tid);
  gload2(rk1, kbase + (size_t)64 * PW, PW, tid); gload2(rv1, vbase + 64, SEQ, tid);
  sstoreK2(rk0, smem, tid); sstoreV2(rv0, smem + 9216, tid);
  __syncthreads();
  for (int n = 0; n <= nlast; n += 2) {
    if (n + 2 <= nlast) { gload2(rk0, kbase + (size_t)(n + 2) * 64 * PW, PW, tid); gload2(rv0, vbase + (n + 2) * 64, SEQ, tid); }
    C2X_COMPUTE(n, smem)
    sstoreK2(rk1, smem + STAGE, tid); sstoreV2(rv1, smem + STAGE + 9216, tid);
    __syncthreads();
    if (n + 3 <= nlast) { gload2(rk1, kbase + (size_t)(n + 3) * 64 * PW, PW, tid); gload2(rv1, vbase + (n + 3) * 64, SEQ, tid); }
    C2X_COMPUTE(n + 1, smem + STAGE)
    if (n + 2 <= nlast) { sstoreK2(rk0, smem, tid); sstoreV2(rv0, smem + 9216, tid); }
    __syncthreads();
  }
#undef C2X_COMPUTE
  la += __shfl_xor(la, 16); la += __shfl_xor(la, 32);
  lb += __shfl_xor(lb, 16); lb += __shfl_xor(lb, 32);
  const float ia = 1.0f / la, ib = 1.0f / lb;
  bf16_t* ypa = ybase + tok0 * ypitch + head * 64;
  bf16_t* ypb = ybase + (tok0 + 16) * ypitch + head * 64;
#pragma unroll
  for (int dt = 0; dt < 4; ++dt) {
    *(uint2*)(ypa + dt * 16 + 4 * g) = make_uint2(pack2(oa[dt][0] * ia, oa[dt][1] * ia), pack2(oa[dt][2] * ia, oa[dt][3] * ia));
    *(uint2*)(ypb + dt * 16 + 4 * g) = make_uint2(pack2(ob[dt][0] * ib, ob[dt][1] * ib), pack2(ob[dt][2] * ib, ob[dt][3] * ib));
  }
}

constexpr int C1_HP = 1028;
template <int MODE>
DI void c1_pass(const bf16_t* kbase, int ntile, int wid, int lr, int g, const bf16x8 (&qf)[4][2], const float (&w)[4][4],
                const unsigned (&pfx)[4], const unsigned (&need)[4], unsigned himask, int shift, unsigned bmask, bool any_tie,
                unsigned* hist, unsigned short* cnt, u64* mrow) {
  bf16x8 kf[4][2], kn[4][2];
  if (wid < ntile) {
#pragma unroll
    for (int kt = 0; kt < 4; ++kt)
#pragma unroll
      for (int ks = 0; ks < 2; ++ks) kf[kt][ks] = *(const bf16x8*)(kbase + (size_t)(wid * 64 + kt * 16) * PW + ks * 32);
  }
#pragma unroll 1
  for (int n = wid; n < ntile; n += 4) {
    {
      const int nn = n + 4 < ntile ? n + 4 : n;
#pragma unroll
      for (int kt = 0; kt < 4; ++kt)
#pragma unroll
        for (int ks = 0; ks < 2; ++ks) kn[kt][ks] = *(const bf16x8*)(kbase + (size_t)(nn * 64 + kt * 16) * PW + ks * 32);
    }
    unsigned base[4] = {0u, 0u, 0u, 0u};
    u64 word[4] = {0ull, 0ull, 0ull, 0ull};
    u64 zword[4] = {0ull, 0ull, 0ull, 0ull};
    if (MODE == 2 && any_tie) {
#pragma unroll
      for (int j = 0; j < 4; ++j) base[j] = cnt[(4 * g + j) * 64 + n];
    }
#pragma unroll
    for (int kt = 0; kt < 4; ++kt) {
      f32x4 sh[4];
#pragma unroll
      for (int h = 0; h < 4; ++h) {
        sh[h] = (f32x4){0.f, 0.f, 0.f, 0.f};
#pragma unroll
        for (int ks = 0; ks < 2; ++ks) sh[h] = MFMA16(qf[h][ks], kf[kt][ks], sh[h]);
      }
#pragma unroll
      for (int j = 0; j < 4; ++j) {
        float sc = w[j][0] * fmaxf(sh[0][j], 0.f) + w[j][1] * fmaxf(sh[1][j], 0.f) + w[j][2] * fmaxf(sh[2][j], 0.f) + w[j][3] * fmaxf(sh[3][j], 0.f);
        sc += 0.0f;
        const unsigned u = sortable(sc);
        if (MODE == 4) {
          const unsigned um = u & himask;
          const bool eq = um == pfx[j], zr = u == 0x80000000u;
          unsigned* qx = hist + (4 * g + j) * C1_HP + 512;
          if (eq) {
            const unsigned bin = u & bmask; atomicAdd(&hist[(4 * g + j) * C1_HP + (bin >> 1)], 1u << ((bin & 1u) * 16u));
            if (!zr) { const unsigned idx = atomicAdd(&qx[320], 1u); if (idx < 64u) qx[256 + idx] = ((unsigned)n << 16) | ((unsigned)(kt * 16 + lr) << 10) | (u & 1023u); }
          }
          word[j] |= (u64)((unsigned)(__ballot(um > pfx[j]) >> (16 * g)) & 0xffffu) << (16 * kt);
          zword[j] |= (u64)((unsigned)(__ballot(zr) >> (16 * g)) & 0xffffu) << (16 * kt);
        } else if (MODE == 0 || MODE == 3) {
          if (MODE == 3) base[j] += __popc((unsigned)(__ballot(u == 0x80000000u) >> (16 * g)) & 0xffffu);
          if (((u ^ pfx[j]) & himask) == 0u) { const unsigned bin = (u >> shift) & bmask; atomicAdd(&hist[(4 * g + j) * C1_HP + (bin >> 1)], 1u << ((bin & 1u) * 16u)); }
        } else {
          const bool eq = u == pfx[j];
          const unsigned fe = (unsigned)(__ballot(eq) >> (16 * g)) & 0xffffu;
          if (MODE == 1) {
            base[j] += __popc(fe);
          } else {
            const unsigned rank = base[j] + __popc(fe & ((1u << lr) - 1u));
            const bool sel = (u > pfx[j]) || (eq && rank < need[j]);
            base[j] += __popc(fe);
            const unsigned fs = (unsigned)(__ballot(sel) >> (16 * g)) & 0xffffu;
            word[j] |= (u64)fs << (16 * kt);
          }
        }
      }
    }
    if ((MODE == 1 || MODE == 3) && lr == 0) {
#pragma unroll
      for (int j = 0; j < 4; ++j) cnt[(4 * g + j) * 64 + n] = (unsigned short)base[j];
    }
    if (MODE == 2 && lr == 0) {
#pragma unroll
      for (int j = 0; j < 4; ++j) mrow[(size_t)(4 * g + j) * 64 + n] = word[j];
    }
    if (MODE == 4 && lr == 0) {
#pragma unroll
      for (int j = 0; j < 4; ++j) { u64* qx = (u64*)(hist + (4 * g + j) * C1_HP + 512); qx[n] = word[j]; qx[64 + n] = zword[j]; }
    }
#pragma unroll
    for (int kt = 0; kt < 4; ++kt)
#pragma unroll
      for (int ks = 0; ks < 2; ++ks) kf[kt][ks] = kn[kt][ks];
  }
}

DI void c1_mfma(const Params& P, int b, int qt, int qs, char* smem) {
  char* ws = P.ws;
  const bf16_t* Pb = (const bf16_t*)(ws + OFF_P);
  u64* mask = (u64*)(ws + OFF_MASK);
  const int tid = TIDX(), lane = tid & 63, wid = tid >> 6, lr = lane & 15, g = lane >> 4;
  const size_t tok0 = (size_t)b * SEQ + qt * 64 + qs * 16;
  const int ntile = qt + 1;
  if (ntile <= 4) {
    for (int i = tid; i < 16 * ntile; i += 256) mask[(tok0 + i / ntile) * 64 + (i % ntile)] = ~0ull;
    return;
  }
  constexpr int HP = C1_HP;
  unsigned* hist = (unsigned*)smem;
  unsigned short* cnt = (unsigned short*)(smem + 16 * HP * 4);
  unsigned* res = (unsigned*)(smem + 16 * HP * 4 + 2048);
  bf16x8 qf[4][2];
#pragma unroll
  for (int h = 0; h < 4; ++h)
#pragma unroll
    for (int ks = 0; ks < 2; ++ks) qf[h][ks] = *(const bf16x8*)(Pb + (tok0 + lr) * PW + C_IQ + h * 64 + ks * 32 + 8 * g);
  float w[4][4];
#pragma unroll
  for (int j = 0; j < 4; ++j) {
    const uint2 wv = *(const uint2*)(Pb + (tok0 + 4 * g + j) * PW + C_IW);
    w[j][0] = lo_f(wv.x); w[j][1] = hi_f(wv.x); w[j][2] = lo_f(wv.y); w[j][3] = hi_f(wv.y);
  }
  const bf16_t* kbase = Pb + ((size_t)b * SEQ + lr) * PW + C_IK + 8 * g;
  u64* mrow = mask + tok0 * 64;
  for (int i = tid; i < 16 * HP; i += 256) hist[i] = 0u;
  if (tid < 16) { res[tid] = 0u; res[16 + tid] = 256u; res[32 + tid] = 0u; }
  if (tid == 0) { res[48] = 0u; res[49] = 0u; res[50] = 0u; }
  bool zflag = false;
  unsigned prefix[4] = {0u, 0u, 0u, 0u}, need[4] = {256u, 256u, 256u, 256u};
  bool any_tie = false;
  __syncthreads();
#pragma unroll 1
  for (int pass = 0; pass < 3; ++pass) {
    const int shift = pass == 0 ? 21 : (pass == 1 ? 10 : 0);
    const int width = pass == 2 ? 10 : 11;
    const unsigned bmask = (1u << width) - 1u;
    const unsigned himask = pass == 0 ? 0u : (0xffffffffu << (shift + width));
    unsigned pfx[4];
#pragma unroll
    for (int j = 0; j < 4; ++j) pfx[j] = pass == 0 ? 0u : (prefix[j] << (shift + width));
    if (pass == 2) c1_pass<4>(kbase, ntile, wid, lr, g, qf, w, pfx, need, himask, shift, bmask, false, hist, cnt, mrow);
    else c1_pass<0>(kbase, ntile, wid, lr, g, qf, w, pfx, need, himask, shift, bmask, false, hist, cnt, mrow);
    __syncthreads();
    {
      const int q = 4 * wid + (lane >> 4), p = lane & 15;
      const int nw = (1 << width) >> 5;
      const unsigned* hq = hist + q * HP + p * nw;
      unsigned S = 0u;
      for (int i = 0; i < nw; i += 4) { const uint4 v = *(const uint4*)(hq + i); S += (v.x & 0xffffu) + (v.x >> 16) + (v.y & 0xffffu) + (v.y >> 16) + (v.z & 0xffffu) + (v.z >> 16) + (v.w & 0xffffu) + (v.w >> 16); }
      unsigned suf = S;
#pragma unroll
      for (int d = 1; d < 16; d <<= 1) { const unsigned t = __shfl_down(suf, d, 16); if (p + d < 16) suf += t; }
      const unsigned above = suf - S;
      const unsigned nd = res[16 + q];
      if (above < nd && nd <= above + S) {
        unsigned cum = above, fbin = 0u, fcum = 0u, fc = 0u; bool found = false;
        for (int i = nw - 1; i >= 0; --i) {
          const unsigned wv = hq[i];
          const unsigned chi = wv >> 16, clo = wv & 0xffffu;
          if (!found && cum + chi >= nd) { found = true; fbin = 2 * (p * nw + i) + 1; fcum = cum; fc = chi; }
          cum += chi;
          if (!found && cum + clo >= nd) { found = true; fbin = 2 * (p * nw + i); fcum = cum; fc = clo; }
          cum += clo;
        }
        const unsigned key = (res[q] << width) | fbin;
        res[q] = key; res[16 + q] = nd - fcum; res[32 + q] = fc;
        if (pass == 2 && nd - fcum < fc) { res[48] = 1u; if (key != 0x80000000u) res[49] = 1u; }
      }
    }
    __syncthreads();
    if (pass < 2) { for (int i = tid; i < 16 * HP; i += 256) hist[i] = 0u; }
#pragma unroll
    for (int j = 0; j < 4; ++j) { prefix[j] = res[4 * g + j]; need[j] = res[16 + 4 * g + j]; }
    any_tie = res[48] != 0u;
    if (pass == 1) {
#pragma unroll
      for (int q = 0; q < 16; ++q) zflag = zflag || (res[q] == (0x80000000u >> 10));
    }
    __syncthreads();
  }
  if (tid < 16 && hist[tid * HP + 512 + 320] > 64u) res[50] = 1u;
  __syncthreads();
  const bool fallback = res[49] != 0u || res[50] != 0u;
  if (!fallback) {
    if (tid < 16) {
      unsigned* qx = hist + tid * HP + 512;
      u64* prov = (u64*)qx; const u64* zw = (const u64*)(qx + 128);
      const unsigned key = res[tid], thr10 = key & 1023u, nc = qx[320];
      for (unsigned i = 0; i < nc; ++i) {
        const unsigned e = qx[256 + i];
        if ((e & 1023u) >= thr10) prov[e >> 16] |= 1ull << ((e >> 10) & 63u);
      }
      if (key == 0x80000000u) {
        unsigned left = res[16 + tid];
        for (int n = 0; n < ntile && left > 0u; ++n) {
          u64 z = zw[n]; const unsigned c = (unsigned)__popcll(z);
          if (c <= left) { prov[n] |= z; left -= c; }
          else { u64 take = 0ull; for (; left > 0u; --left) { const u64 t = z & (0ull - z); take |= t; z ^= t; } prov[n] |= take; }
        }
      }
    }
    __syncthreads();
    for (int i = tid; i < 16 * ntile; i += 256) { const int q = i / ntile, n = i - q * ntile; mrow[(size_t)q * 64 + n] = ((const u64*)(hist + q * HP + 512))[n]; }
    return;
  }
  if (any_tie) {
    __syncthreads();
    c1_pass<1>(kbase, ntile, wid, lr, g, qf, w, prefix, need, 0u, 0, 0u, true, hist, cnt, mrow);
    __syncthreads();
    if (tid < 16) {
      unsigned run = 0u;
      for (int n = 0; n < ntile; ++n) { const unsigned c = cnt[tid * 64 + n]; cnt[tid * 64 + n] = (unsigned short)run; run += c; }
    }
    __syncthreads();
  }
  c1_pass<2>(kbase, ntile, wid, lr, g, qf, w, prefix, need, 0u, 0, 0u, any_tie, hist, cnt, mrow);
}

DI void phase_attn1(const Params& P, int l, char* smem, bool dry, int only = 0) {
  unsigned* ctr = (unsigned*)(P.ws + OFF_CTR) + l * 4 + (dry ? 2 : 0);
  bf16_t* Pb_ = (bf16_t*)(P.ws + OFF_P); bf16_t* xb_ = (bf16_t*)(P.ws + OFF_XB);
  bf16_t* ya = dry ? xb_ : Pb_ + C_AQ; bf16_t* yb = dry ? xb_ + 512 : Pb_ + C_BQ; const size_t yp_ = dry ? 1024 : PW;
  const float lam = compute_lam(P, l);
  const int per = 16 + 16 + 32, total = 64 * per;
  for (;;) {
    const int it = next_item(ctr, smem);
    if (it >= total) break;
    const int qt = 63 - it / per, r = it % per;
    if (only && (only == 1) != (r < 16) && (only == 2) != (r >= 16 && r < 32) && (only == 3) != (r >= 32)) continue;
    if (only && !((only == 1 && r < 16) || (only == 2 && r >= 16 && r < 32) || (only == 3 && r >= 32))) continue;
    if (r < 16) c1_mfma(P, r >> 2, qt, r & 3, smem);
    else if (r < 32) attn_A(P, l, (r - 16) >> 2, (r - 16) & 3, qt, lam, smem, ya, yp_);
    else attn_B(P, (r - 32) >> 3, (r - 32) & 7, qt, smem, yb, yp_);
  }
}
DI void phase_attn2(const Params& P, int l, char* smem, bool dry) {
  unsigned* ctr = (unsigned*)(P.ws + OFF_CTR) + l * 4 + (dry ? 3 : 1);
  bf16_t* yc = dry ? (bf16_t*)(P.ws + OFF_XB) : (bf16_t*)(P.ws + OFF_P) + C_CQ; const size_t yp_ = dry ? 1024 : PW;
  const int total = 32 * 32;
  for (;;) {
    const int it = next_item(ctr, smem);
    if (it >= total) break;
    const int qp = 31 - it / 32, r = it % 32;
    attn_C2x(P, r >> 3, r & 7, qp, smem, yc, yp_);
  }
}

DI void phase_merge(const Params& P, int l, char* smem) {
  char* ws = P.ws;
  const bf16_t* Pb = (const bf16_t*)(ws + OFF_P);
  const bf16_t* W = (const bf16_t*)(ws + OFF_W) + (size_t)l * W_LAYER;
  bf16_t* MB = (bf16_t*)(ws + OFF_VT);
  const int tid = TIDX(), lane = tid & 63, wid = tid >> 6, wm = wid >> 1, wn = wid & 1, lr = lane & 15, g = lane >> 4;
  {
    const float4* src = (const float4*)(P.p + (size_t)l * NTOK * PLE); uint2* dst = (uint2*)(ws + OFF_PB);
    for (int i = BIDX() * 256 + tid; i < NTOK * PLE / 4; i += gridDim.x * 256) { const float4 v = src[i]; dst[i] = make_uint2(pack2(v.x, v.y), pack2(v.z, v.w)); }
  }
  for (int vb = BIDX(); vb < tile_groups(128, 8); vb += gridDim.x) {
    int tm, tn; if (!tile_of(vb, 128, 8, tm, tn)) continue;
    const int m0 = tm * 128, n0 = tn * 128;
    const int row0 = m0 + wm * 64, col0 = n0 + wn * 64;
    unsigned tot[4][4][2];
#pragma unroll 1
    for (int br = 0; br < 3; ++br) {
      f32x4 acc[4][4]; zero_acc(acc);
      const int ycol = br == 0 ? C_AQ : (br == 1 ? C_BQ : C_CQ);
      const bf16_t* Wb = W + (br == 0 ? WO_BRA : (br == 1 ? WO_BRB : WO_BRC));
      gemm_kloop<false, true, 8>(acc, Pb + (size_t)m0 * PW + ycol, PW, Wb + (size_t)n0 * 512, 512, smem);
#pragma unroll
      for (int mt = 0; mt < 4; ++mt) {
        const int row = row0 + mt * 16 + lr;
#pragma unroll
        for (int nt = 0; nt < 4; ++nt) {
          const uint2 gu = *(const uint2*)(Pb + (size_t)row * PW + C_GL + br * 1024 + col0 + nt * 16 + 4 * g);
          float t0 = lo_f(gu.x) * acc[mt][nt][0], t1 = hi_f(gu.x) * acc[mt][nt][1], t2 = lo_f(gu.y) * acc[mt][nt][2], t3 = hi_f(gu.y) * acc[mt][nt][3];
          if (br > 0) { t0 += lo_f(tot[mt][nt][0]); t1 += hi_f(tot[mt][nt][0]); t2 += lo_f(tot[mt][nt][1]); t3 += hi_f(tot[mt][nt][1]); }
          tot[mt][nt][0] = pack2(t0, t1); tot[mt][nt][1] = pack2(t2, t3);
        }
      }
    }
#pragma unroll
    for (int mt = 0; mt < 4; ++mt) {
      const int row = row0 + mt * 16 + lr;
#pragma unroll
      for (int nt = 0; nt < 4; ++nt)
        *(uint2*)(MB + (size_t)row * DM + col0 + nt * 16 + 4 * g) = make_uint2(tot[mt][nt][0], tot[mt][nt][1]);
    }
  }
}

DI void phase_resgemm(const Params& P, const bf16_t* A, int K, const bf16_t* Wt, float* ssq_out, char* smem) {
  bf16_t* xb = (bf16_t*)(P.ws + OFF_XB);
  const int wid = TIDX() >> 6, wm = wid >> 1, wn = wid & 1;
  for (int vb = BIDX(); vb < tile_groups(128, 8); vb += gridDim.x) {
    int tm, tn; if (!tile_of(vb, 128, 8, tm, tn)) continue;
    const int m0 = tm * 128, n0 = tn * 128;
    f32x4 acc[4][4]; zero_acc(acc);
    if (K == 1024) gemm_kloop<false, true, 16>(acc, A + (size_t)m0 * K, K, Wt + (size_t)n0 * K, K, smem);
    else gemm_kloop<false, true, 64>(acc, A + (size_t)m0 * K, K, Wt + (size_t)n0 * K, K, smem);
    epi_residual(acc, m0 + wm * 64, n0 + wn * 64, P.out, xb, ssq_out, true, true);
  }
}

template <int VAR> DI void phase_up(const Params& P, int l, char* smem) {
  char* ws = P.ws;
  const bf16_t* xb = (const bf16_t*)(ws + OFF_XB);
  const bf16_t* Wt = (const bf16_t*)(ws + OFF_W) + (size_t)l * W_LAYER + WO_UP;
  bf16_t* U = (bf16_t*)(ws + OFF_P);
  const float* ssq = (const float*)(ws + OFF_SSQ) + (size_t)1 * NTOK * 16;
  const int tid = TIDX(), lane = tid & 63, wid = tid >> 6, wm = wid >> 1, wn = wid & 1, lr = lane & 15, g = lane >> 4;
  for (int vb = BIDX(); vb < tile_groups(128, 32); vb += gridDim.x) {
    int tm, tn; if (!tile_of(vb, 128, 32, tm, tn)) continue;
    const int m0 = tm * 128, n0 = tn * 128;
    const int row0 = m0 + wm * 64, col0 = n0 + wn * 64;
    f32x4 acc[4][4]; zero_acc(acc);
    float rs[4]; load_rstd(rs, ssq, row0, lr);
    gemm_kloop<false, true, 16, VAR>(acc, xb + (size_t)m0 * DM, DM, Wt + (size_t)n0 * DM, DM, smem);
#pragma unroll
    for (int mt = 0; mt < 4; ++mt) {
      const int row = row0 + mt * 16 + lr;
#pragma unroll
      for (int nt = 0; nt < 4; ++nt) {
        float v[4];
#pragma unroll
        for (int j = 0; j < 4; ++j) { const float a = fmaxf(acc[mt][nt][j] * rs[mt], 0.f); v[j] = a * a; }
        *(uint2*)(U + (size_t)row * DFF + col0 + nt * 16 + 4 * g) = make_uint2(pack2(v[0], v[1]), pack2(v[2], v[3]));
      }
    }
  }
}

DI void phase_ple(const Params& P, int l, char* smem) {
  char* ws = P.ws;
  bf16_t* xb = (bf16_t*)(ws + OFF_XB);
  const bf16_t* W = (const bf16_t*)(ws + OFF_W) + (size_t)l * W_LAYER;
  const float* ssq = (const float*)(ws + OFF_SSQ) + (size_t)2 * NTOK * 16;
  float* ssq_out = (float*)(ws + OFF_SSQ);
  const bf16_t* pl = (const bf16_t*)(ws + OFF_PB);
  bf16_t* xb2 = (bf16_t*)(ws + OFF_XB2);
  const int tid = TIDX(), lane = tid & 63, wid = tid >> 6, wm = wid >> 1, wn = wid & 1, lr = lane & 15;
  for (int vb = BIDX(); vb < tile_groups(128, 8); vb += gridDim.x) {
    int tm, tn; if (!tile_of(vb, 128, 8, tm, tn)) continue;
    const int m0 = tm * 128, n0 = tn * 128;
    const int row0 = m0 + wm * 64, col0 = n0 + wn * 64;
    uint4* park = (uint4*)(ws + OFF_VT) + ((size_t)BIDX() * 256 + tid) * 8;
    {
      f32x4 pp[4][4]; zero_acc(pp);
      gemm_kloop<false, true, 4>(pp, pl + (size_t)m0 * PLE, PLE, W + WO_PP + (size_t)n0 * PLE, PLE, smem);
#pragma unroll
      for (int mt = 0; mt < 4; ++mt)
#pragma unroll
        for (int h = 0; h < 2; ++h)
          park[mt * 2 + h] = make_uint4(pack2(pp[mt][2 * h][0], pp[mt][2 * h][1]), pack2(pp[mt][2 * h][2], pp[mt][2 * h][3]), pack2(pp[mt][2 * h + 1][0], pp[mt][2 * h + 1][1]), pack2(pp[mt][2 * h + 1][2], pp[mt][2 * h + 1][3]));
    }
    f32x4 acc[4][4]; zero_acc(acc);
    float rs[4]; load_rstd(rs, ssq, row0, lr);
    gemm_kloop<false, true, 16>(acc, xb + (size_t)m0 * DM, DM, W + WO_GATE + (size_t)n0 * DM, DM, smem);
#pragma unroll
    for (int mt = 0; mt < 4; ++mt)
#pragma unroll
      for (int h = 0; h < 2; ++h) {
        const uint4 q = park[mt * 2 + h];
        acc[mt][2 * h][0] = sigmoidf_(acc[mt][2 * h][0] * rs[mt]) * lo_f(q.x);
        acc[mt][2 * h][1] = sigmoidf_(acc[mt][2 * h][1] * rs[mt]) * hi_f(q.x);
        acc[mt][2 * h][2] = sigmoidf_(acc[mt][2 * h][2] * rs[mt]) * lo_f(q.y);
        acc[mt][2 * h][3] = sigmoidf_(acc[mt][2 * h][3] * rs[mt]) * hi_f(q.y);
        acc[mt][2 * h + 1][0] = sigmoidf_(acc[mt][2 * h + 1][0] * rs[mt]) * lo_f(q.z);
        acc[mt][2 * h + 1][1] = sigmoidf_(acc[mt][2 * h + 1][1] * rs[mt]) * hi_f(q.z);
        acc[mt][2 * h + 1][2] = sigmoidf_(acc[mt][2 * h + 1][2] * rs[mt]) * lo_f(q.w);
        acc[mt][2 * h + 1][3] = sigmoidf_(acc[mt][2 * h + 1][3] * rs[mt]) * hi_f(q.w);
      }
    epi_residual(acc, row0, col0, P.out, xb2, ssq_out, l + 1 < DEPTH, l + 1 < DEPTH);
  }
}


#define XB_TMO      128
#define XB_XCNT(j)  (256  + 64 * (j))
#define XB_XSUB(j)  (1280 + 64 * (j))
#define XB_XGEN(j)  (2304 + 64 * (j))
#define XB_TOP      3328
#define XB_TOPGEN   3392
#define XCD_BAR_WORDS 3456
#define XB_SPIN_CAP (1u << 20)
#define LAS __attribute__((address_space(3)))
DI unsigned xb_ld(unsigned* p)              { return __hip_atomic_load(p, __ATOMIC_RELAXED, __HIP_MEMORY_SCOPE_AGENT); }
DI unsigned xb_add(unsigned* p, unsigned v) { return __hip_atomic_fetch_add(p, v, __ATOMIC_RELAXED, __HIP_MEMORY_SCOPE_AGENT); }
DI unsigned xb_xcc_id() { return (unsigned)__builtin_amdgcn_s_getreg((3 << 11) | 20) & 0xFu; }
#define XB_SPIN(cond, bar) do { unsigned _sp = 0; while (cond) { __builtin_amdgcn_s_sleep(1); \
    if ((++_sp & 255u) == 0u) { if (xb_ld(&(bar)[XB_TMO])) break; if (_sp > XB_SPIN_CAP) { atomicAdd(&(bar)[XB_TMO], 1u); break; } } } } while (0)
struct XcdBarrier { unsigned* bar; unsigned x; volatile LAS unsigned* st; };
DI XcdBarrier xcd_barrier_post(unsigned* bar, volatile LAS unsigned* st) {
  XcdBarrier b; b.bar = bar; b.x = xb_xcc_id(); b.st = st;
  if (threadIdx.x == 0) (void)xb_add(&bar[XB_XCNT(b.x)], 1u);
  return b;
}
DI void xcd_barrier_complete(unsigned* bar, unsigned x, unsigned& nloc, unsigned& nx) {
  const unsigned G = gridDim.x * gridDim.y * gridDim.z;
  unsigned sum, cnt, mine, sp = 0u;
  for (;;) {
    sum = 0u; cnt = 0u; mine = 0u;
#pragma unroll
    for (unsigned j = 0; j < 16; ++j) { const unsigned c = xb_ld(&bar[XB_XCNT(j)]); sum += c; cnt += (c > 0u) ? 1u : 0u; mine = (j == x) ? c : mine; }
    if (sum == G) break;
    __builtin_amdgcn_s_sleep(1);
    if ((++sp & 255u) == 0u) { if (xb_ld(&bar[XB_TMO])) break; if (sp > XB_SPIN_CAP) { atomicAdd(&bar[XB_TMO], 1u); break; } }
  }
  nloc = mine > 0u ? mine : 1u; nx = cnt > 0u ? cnt : 1u;
}
DI void xcd_barrier(const XcdBarrier& b) {
  asm volatile("s_waitcnt vmcnt(0)" ::: "memory");
  __syncthreads();
  if (threadIdx.x == 0) {
    unsigned* bar = b.bar;
    __builtin_amdgcn_s_waitcnt(0);
    unsigned nloc = b.st[0], nx = b.st[1];
    if (nloc == 0u) { xcd_barrier_complete(bar, b.x, nloc, nx); b.st[0] = nloc; b.st[1] = nx; }
    const unsigned old = xb_add(&bar[XB_XSUB(b.x)], 1u);
    const unsigned gen = old / nloc;
    if (old + 1u == (gen + 1u) * nloc) {
      __builtin_amdgcn_fence(__ATOMIC_RELEASE, "agent");
      asm volatile("s_waitcnt vmcnt(0)" ::: "memory");
      const unsigned og = xb_add(&bar[XB_TOP], 1u);
      const unsigned tg = og / nx;
      if (og + 1u == (tg + 1u) * nx) xb_add(&bar[XB_TOPGEN], 1u);
      else XB_SPIN(xb_ld(&bar[XB_TOPGEN]) == tg, bar);
      __builtin_amdgcn_fence(__ATOMIC_ACQUIRE, "agent");
      xb_add(&bar[XB_XGEN(b.x)], 1u);
      asm volatile("s_waitcnt vmcnt(0)" ::: "memory");
    } else {
      XB_SPIN(xb_ld(&bar[XB_XGEN(b.x)]) == gen, bar);
      __builtin_amdgcn_fence(__ATOMIC_ACQUIRE, "agent");
      asm volatile("s_waitcnt vmcnt(0)" ::: "memory");
    }
  }
  __syncthreads();
}

template <int PH> DI void run_phase(const Params& P, int l, char* smem, bool dry = false) {
  char* ws = P.ws;
  if (PH == 0) phase0(P, smem);
  if (PH == 1) phase_proj(P, l, smem);
  if (PH == 2) phase_attn1(P, l, smem, dry, dry ? (PROBE_REP >= 21 ? PROBE_REP - 20 : 0) : 0);
  if (PH == 3) phase_attn2(P, l, smem, dry);
  if (PH == 4) phase_merge(P, l, smem);
  if (PH == 5) phase_resgemm(P, (const bf16_t*)(ws + OFF_VT), 1024, (const bf16_t*)(ws + OFF_W) + (size_t)l * W_LAYER + WO_OUT, (float*)(ws + OFF_SSQ) + (size_t)1 * NTOK * 16, smem);
  if (PH == 6) { if (dry) phase_up<PROBE_VAR>(P, l, smem); else phase_up<0>(P, l, smem); }
  if (PH == 7) phase_resgemm(P, (const bf16_t*)(ws + OFF_P), 4096, (const bf16_t*)(ws + OFF_W) + (size_t)l * W_LAYER + WO_DOWN, (float*)(ws + OFF_SSQ) + (size_t)2 * NTOK * 16, smem);
  if (PH == 8) phase_ple(P, l, smem);
}

#if MULTI_LAUNCH
template <int PH> __global__ void __launch_bounds__(256, 2) phase_kernel(Params P, int l) {
  __shared__ __attribute__((aligned(16))) char smem[SMEM_TOTAL];
  run_phase<PH>(P, l, smem);
}
#else
__global__ void __launch_bounds__(256, 2) fwd_megakernel(Params P) {
  __shared__ __attribute__((aligned(16))) char smem[SMEM_TOTAL];
  __shared__ uint4 xb_words;
  cg::grid_group grid = cg::this_grid();
  if (threadIdx.x == 0) xb_words = make_uint4(0u, 0u, 0u, 0u);
  if (blockIdx.x == 0) { unsigned* z = (unsigned*)(P.ws + OFF_CTR); for (int i = threadIdx.x; i < (4096 + 16384) / 4; i += 256) z[i] = 0u; }
  __syncthreads();
  XcdBarrier xb; xb.bar = (unsigned*)(P.ws + OFF_BAR); xb.x = xb_xcc_id(); xb.st = (volatile LAS unsigned*)&xb_words;
#define GSYNC() xcd_barrier(xb)
  run_phase<0>(P, 0, smem);
  grid.sync();
  if (threadIdx.x == 0) (void)xb_add(&xb.bar[XB_XCNT(xb.x)], 1u);
  if (PROBE_REP == 10) { run_phase<0>(P, 0, smem); GSYNC(); }
  if (PROBE_REP == 11) { for (int i = 0; i < 40; ++i) GSYNC(); }
  for (int l = 0; l < DEPTH; ++l) {
    if (PROBE_REP == 1) { run_phase<1>(P, l, smem); GSYNC(); }
    run_phase<1>(P, l, smem); GSYNC();
    if (PROBE_REP == 2 || PROBE_REP >= 21) { run_phase<2>(P, l, smem, true); GSYNC(); }
    run_phase<2>(P, l, smem); GSYNC();
    if (PROBE_REP == 3) { run_phase<3>(P, l, smem, true); GSYNC(); }
    run_phase<3>(P, l, smem); GSYNC();
    if (PROBE_REP == 4) { run_phase<4>(P, l, smem); GSYNC(); }
    run_phase<4>(P, l, smem); GSYNC();
    run_phase<5>(P, l, smem); GSYNC();
    if (PROBE_REP == 6) { run_phase<6>(P, l, smem, true); GSYNC(); }
    run_phase<6>(P, l, smem); GSYNC();
    run_phase<7>(P, l, smem); GSYNC();
    run_phase<8>(P, l, smem);
    if (l + 1 < DEPTH) GSYNC();
  }
#undef GSYNC
}
#endif

extern "C" void kernel_launch(void* const* d_in, const int* in_sizes, int n_in, void* d_out, int out_size, void* d_ws, size_t ws_size, hipStream_t stream) {
  Params P{};
  P.x = (const float*)d_in[0]; P.p = (const float*)d_in[1]; P.pos = (const int*)d_in[2];
  P.attn_norm = (const float*)d_in[3]; P.w_in = (const float*)d_in[4]; P.a_q_norm = (const float*)d_in[5]; P.a_k_norm = (const float*)d_in[6];
  P.a_lambda = (const float*)d_in[7]; P.a_subln = (const float*)d_in[8]; P.c_q_norm = (const float*)d_in[9]; P.c_k_norm = (const float*)d_in[10];
  P.idx_k_norm = (const float*)d_in[11]; P.w_br_a = (const float*)d_in[12]; P.w_br_b = (const float*)d_in[13]; P.w_br_c = (const float*)d_in[14];
  P.w_out = (const float*)d_in[15]; P.mlp_norm = (const float*)d_in[16]; P.w_up = (const float*)d_in[17]; P.w_down = (const float*)d_in[18];
  P.ple_norm = (const float*)d_in[19]; P.w_ple_gate = (const float*)d_in[20]; P.w_ple_proj = (const float*)d_in[21];
  P.out = (float*)d_out; P.ws = (char*)d_ws;
  for (int i = 0; i < 32; ++i) P.inv_freq[i] = powf(10000.0f, -(float)(2 * i) / 64.0f);
  for (int i = 0; i < 4; ++i) P.lam_init[i] = (float)(0.8 - 0.6 * exp(-0.3 * (double)i));
  if (ws_size < WS_NEED) { fprintf(stderr, "workspace too small: %zu < %zu\n", ws_size, (size_t)WS_NEED); return; }
#if MULTI_LAUNCH
  const int G = 512;
  phase_kernel<0><<<G, 256, 0, stream>>>(P, 0);
  for (int l = 0; l < DEPTH; ++l) {
    phase_kernel<1><<<G, 256, 0, stream>>>(P, l);
    phase_kernel<2><<<G, 256, 0, stream>>>(P, l);
    phase_kernel<3><<<G, 256, 0, stream>>>(P, l);
    phase_kernel<4><<<G, 256, 0, stream>>>(P, l);
    phase_kernel<5><<<G, 256, 0, stream>>>(P, l);
    phase_kernel<6><<<G, 256, 0, stream>>>(P, l);
    phase_kernel<7><<<G, 256, 0, stream>>>(P, l);
    phase_kernel<8><<<G, 256, 0, stream>>>(P, l);
  }
#else
  static int grid_blocks = 0;
  if (!grid_blocks) {
    int dev = 0, cus = 0, per_cu = 0;
    hipGetDevice(&dev);
    hipDeviceGetAttribute(&cus, hipDeviceAttributeMultiprocessorCount, dev);
    hipOccupancyMaxActiveBlocksPerMultiprocessor(&per_cu, fwd_megakernel, 256, 0);
    if (per_cu > 2) per_cu = 2;
    grid_blocks = cus * per_cu;
  }
  void* args[] = {&P};
  hipError_t e = hipLaunchCooperativeKernel((void*)fwd_megakernel, dim3(grid_blocks), dim3(256), args, 0, stream);
  if (e != hipSuccess) fprintf(stderr, "cooperative launch failed: %s (grid %d)\n", hipGetErrorString(e), grid_blocks);
#endif
}
```
